# Optimizing an MI355X kernel written in HIP

```python
import math
import jax, jax.numpy as jnp
from jax import lax
import numpy as np

D_MODEL = 1024
BATCH = 32
SEQ = 256
DEPTH = 2
DEC_BATCH = 8
DEC_SEQ = 4096
PAST_LEN = 512

GRID_W = 64
CHUNK = 64
N_BRANCH = 4
MIX_W = 512
RET_H = 4
RET_DK = 64
RET_DV = 128
SSD_H = 8
SSD_P = 64
SSD_N = 64
SSD_G = 2
SSD_CONV_DIM = MIX_W + 2 * SSD_G * SSD_N
RWKV_H = 8
RWKV_D = 64
RWKV_W_LORA = 64
RWKV_A_LORA = 64
RWKV_G_LORA = 128
ML_H = 4
ML_DK = 64
ML_DV = 128
FFN_DIM = 2816
CONV_W = 3
ROPE_BASE = 10000.0
EPS = 1e-6
GN_EPS = 1e-5
RWKV_GN_EPS = 64e-5

IN_SPLITS = (
    RET_H * RET_DK, RET_H * RET_DK, MIX_W, MIX_W,
    MIX_W, SSD_CONV_DIM, 2 * SSD_H,
    3 * MIX_W, RWKV_W_LORA, RWKV_A_LORA, RWKV_G_LORA,
    ML_H * ML_DK, ML_H * ML_DK, MIX_W, MIX_W, 4 * ML_H,
    N_BRANCH * D_MODEL,
)
IN_DIM = sum(IN_SPLITS)

kernel_name = 'bidir_hybrid_ret_ssd_rwkv7_mlstm_diffusion_step'


def _split(a, sizes):
    out, o = [], 0
    for s in sizes:
        out.append(a[..., o:o + s])
        o += s
    return out


def _rev(a):
    return jnp.flip(a, axis=1)


def _rms(x, w):
    xf = x.astype(jnp.float32)
    y = xf * lax.rsqrt(jnp.mean(xf * xf, axis=-1, keepdims=True) + EPS)
    return (y * w).astype(x.dtype)


def _head_norm(y, eps):
    yf = y.astype(jnp.float32)
    mu = jnp.mean(yf, axis=-1, keepdims=True)
    var = jnp.var(yf, axis=-1, keepdims=True)
    return (yf - mu) * lax.rsqrt(var + eps)


def _dwconv3(x, w, b=None):
    xp = jnp.pad(x, ((0, 0), (1, 1), (0, 0)))
    y = xp[:, :-2] * w[0] + xp[:, 1:-1] * w[1] + xp[:, 2:] * w[2]
    return y if b is None else y + b


def _grid_rope(n_tok):
    rows = n_tok // GRID_W
    rr, cc = jnp.meshgrid(jnp.arange(rows), jnp.arange(GRID_W), indexing='ij')
    nf = RET_DK // 4
    inv = ROPE_BASE ** (-jnp.arange(nf, dtype=jnp.float32) / nf)
    ang = jnp.concatenate([rr.reshape(-1, 1) * inv, cc.reshape(-1, 1) * inv], axis=-1)
    return jnp.cos(ang), jnp.sin(ang)


def _apply_rope(x, cos, sin):
    half = x.shape[-1] // 2
    x1, x2 = x[..., :half], x[..., half:]
    c, s = cos[None, :, None, :], sin[None, :, None, :]
    return jnp.concatenate([x1 * c - x2 * s, x1 * s + x2 * c], axis=-1)


def _chunks(a):
    b, t = a.shape[:2]
    return jnp.moveaxis(a.reshape(b, t // CHUNK, CHUNK, *a.shape[2:]), 1, 0)


def _unchunks(a):
    n, b = a.shape[:2]
    return jnp.moveaxis(a, 0, 1).reshape(b, n * CHUNK, *a.shape[3:])


def _decay_scan(q, k, v, logd, s0):
    f32 = jnp.float32
    causal = jnp.tril(jnp.ones((CHUNK, CHUNK), bool))[None, :, :, None]

    def step(s, blk):
        qb, kb, vb, lb = blk
        cs = jnp.cumsum(lb, axis=1)
        dmat = jnp.exp(jnp.where(causal, cs[:, :, None] - cs[:, None], -jnp.inf))
        att = jnp.einsum('blhk,bshk->blsh', qb, kb) * dmat
        y = (jnp.einsum('blsh,bshv->blhv', att, vb)
             + jnp.einsum('blhk,bhkv->blhv', qb * jnp.exp(cs)[..., None], s))
        tail = jnp.exp(cs[:, -1:] - cs)[..., None]
        s = jnp.exp(cs[:, -1])[..., None, None] * s + jnp.einsum('blhk,blhv->bhkv', kb * tail, vb)
        return s, y

    s, ys = lax.scan(step, s0.astype(f32), tuple(_chunks(a.astype(f32)) for a in (q, k, v, logd)))
    return _unchunks(ys), s


def _mlstm_scan(q, k, v, ig, lf, state):
    f32 = jnp.float32
    causal = jnp.tril(jnp.ones((CHUNK, CHUNK), bool))[None, :, :, None]

    def step(carry, blk):
        c, n, m = carry
        qb, kb, vb, ib, fb = blk
        b = jnp.cumsum(fb, axis=1)
        logw = jnp.where(causal, b[:, :, None] - b[:, None] + ib[:, None], -jnp.inf)
        inter = b + m[:, None]
        mt = jnp.maximum(inter, jnp.max(logw, axis=2))
        att = jnp.einsum('blhk,bshk->blsh', qb, kb) * jnp.exp(logw - mt[:, :, None])
        a_in = jnp.exp(inter - mt)
        num = (jnp.einsum('blsh,bshv->blhv', att, vb)
               + a_in[..., None] * jnp.einsum('blhk,bhkv->blhv', qb, c))
        den = jnp.sum(att, axis=2) + a_in * jnp.einsum('blhk,bhk->blh', qb, n)
        y = num / jnp.maximum(jnp.abs(den), jnp.exp(-mt))[..., None]
        b_end = b[:, -1]
        logw_end = b_end[:, None] - b + ib
        m_new = jnp.maximum(b_end + m, jnp.max(logw_end, axis=1))
        w_end = jnp.exp(logw_end - m_new[:, None])[..., None]
        scale = jnp.exp(b_end + m - m_new)
        c = scale[..., None, None] * c + jnp.einsum('blhk,blhv->bhkv', kb * w_end, vb)
        n = scale[..., None] * n + jnp.sum(kb * w_end, axis=1)
        return (c, n, m_new), y

    init = tuple(a.astype(f32) for a in state)
    carry, ys = lax.scan(step, init, tuple(_chunks(a.astype(f32)) for a in (q, k, v, ig, lf)))
    return _unchunks(ys), carry


def _rwkv_scan(r, w, k, v, a, b, s0):
    f32 = jnp.float32

    def step(s, tok):
        rt, wt, kt, vt, at, bt = tok
        sa = jnp.einsum('bhvk,bhk->bhv', s, at)
        s = s * wt[:, :, None] + sa[..., None] * bt[:, :, None] + vt[..., None] * kt[:, :, None]
        return s, jnp.einsum('bhvk,bhk->bhv', s, rt)

    seqs = tuple(jnp.moveaxis(x.astype(f32), 1, 0) for x in (r, w, k, v, a, b))
    s, ys = lax.scan(step, s0.astype(f32), seqs)
    return jnp.moveaxis(ys, 0, 1), s


def _run_dir(scan, seqs, state, backward):
    if backward:
        y, state = scan(*(_rev(a) for a in seqs), state)
        return _rev(y), state
    return scan(*seqs, state)


def _mixer(h, lp, state, rope):
    B, T, _ = h.shape
    f32 = jnp.float32
    (rq, rk, rv, rg, sz, sxbc, sdt, wrkv, wwd, wad, wgd,
     mq, mk, mv, mo, mif, mg) = _split(h @ lp['w_in'], IN_SPLITS)
    st_ret, st_ssd, st_rwkv, st_c, st_n, st_m = state

    q = rq.reshape(B, T, RET_H, RET_DK)
    k = rk.reshape(B, T, RET_H, RET_DK)
    v = rv.reshape(B, T, RET_H, RET_DV)
    if rope is not None:
        q, k = _apply_rope(q, *rope), _apply_rope(k, *rope)
    q = q * RET_DK ** -0.5
    log_gamma = -jnp.exp(lp['ret_log_rate'].astype(f32))
    ys, ss = [], []
    for d in range(2):
        logd = jnp.broadcast_to(log_gamma[d], (B, T, RET_H))
        y, s = _run_dir(_decay_scan, (q, k, v, logd), st_ret[:, d], d == 1)
        ys.append(y)
        ss.append(s)
    y_ret = jax.nn.silu(rg) * _head_norm(ys[0] + ys[1], GN_EPS).reshape(B, T, MIX_W)
    new_ret = jnp.stack(ss, axis=1)

    xbc = jax.nn.silu(_dwconv3(sxbc, lp['ssd_conv_w'], lp['ssd_conv_b']))
    xs, bm, cm = _split(xbc, (MIX_W, SSD_G * SSD_N, SSD_G * SSD_N))
    xs = xs.reshape(B, T, SSD_H, SSD_P).astype(f32)
    bm = jnp.repeat(bm.reshape(B, T, SSD_G, SSD_N), SSD_H // SSD_G, axis=2)
    cm = jnp.repeat(cm.reshape(B, T, SSD_G, SSD_N), SSD_H // SSD_G, axis=2)
    dt = jax.nn.softplus(sdt.reshape(B, T, 2, SSD_H).astype(f32) + lp['ssd_dt_bias'])
    a_neg = -jnp.exp(lp['ssd_A_log'].astype(f32))
    ys, ss = [], []
    for d in range(2):
        seqs = (cm, bm, xs * dt[:, :, d, :, None], dt[:, :, d] * a_neg[d])
        y, s = _run_dir(_decay_scan, seqs, st_ssd[:, d], d == 1)
        ys.append(y)
        ss.append(s)
    y = ys[0] + ys[1] + (lp['ssd_D'][0] + lp['ssd_D'][1])[:, None] * xs
    y_ssd = _rms(y.reshape(B, T, MIX_W) * jax.nn.silu(sz), lp['ssd_norm'])
    new_ssd = jnp.stack(ss, axis=1)

    hd = (RWKV_H, RWKV_D)
    r_, k_, v_ = (a.reshape(B, T, *hd).astype(f32)
                  for a in _split(_dwconv3(wrkv, lp['rwkv_conv_w']), (MIX_W,) * 3))
    g = jax.nn.sigmoid(wgd) @ lp['rwkv_g_up']
    kk = k_ * lp['rwkv_k_k'].reshape(hd)
    kk = kk / jnp.maximum(jnp.linalg.norm(kk, axis=-1, keepdims=True), 1e-12)
    w_low = jnp.tanh(wwd)
    r_bonus = lp['rwkv_r_k'].reshape(hd)
    ys, ss, bonus = [], [], []
    for d in range(2):
        w_log = -jax.nn.softplus(-(lp['rwkv_w0'][d] + w_low @ lp['rwkv_w_up'][d])) - 0.5
        decay = jnp.exp(-jnp.exp(w_log.astype(f32))).reshape(B, T, *hd)
        iclr = jax.nn.sigmoid(lp['rwkv_a0'][d] + wad @ lp['rwkv_a_up'][d]).astype(f32).reshape(B, T, *hd)
        kd = k_ * (1.0 + (iclr - 1.0) * lp['rwkv_k_a'].reshape(hd))
        y, s = _run_dir(_rwkv_scan, (r_, decay, kd, v_, -kk, kk * iclr), st_rwkv[:, d], d == 1)
        ys.append(y)
        ss.append(s)
        bonus.append(jnp.sum(r_ * kd * r_bonus, axis=-1, keepdims=True) * v_)
    y_rw = (_head_norm(ys[0] + ys[1], RWKV_GN_EPS).reshape(B, T, MIX_W) * lp['rwkv_ln_w']
            + lp['rwkv_ln_b'] + (bonus[0] + bonus[1]).reshape(B, T, MIX_W)) * g
    new_rwkv = jnp.stack(ss, axis=1)

    q = mq.reshape(B, T, ML_H, ML_DK) * ML_DK ** -0.5
    k = mk.reshape(B, T, ML_H, ML_DK)
    v = mv.reshape(B, T, ML_H, ML_DV)
    gif = mif.reshape(B, T, 2, 2, ML_H).astype(f32)
    i_pre = gif[:, :, :, 0] + lp['ml_i_bias']
    log_f = jax.nn.log_sigmoid(gif[:, :, :, 1] + lp['ml_f_bias'])
    ys, ss = [], []
    for d in range(2):
        y, s = _run_dir(_mlstm_scan, (q, k, v, i_pre[:, :, d], log_f[:, :, d]),
                        (st_c[:, d], st_n[:, d], st_m[:, d]), d == 1)
        ys.append(y)
        ss.append(s)
    y_ml = jax.nn.sigmoid(mo) * (_head_norm(ys[0] + ys[1], GN_EPS).reshape(B, T, MIX_W) * lp['ml_norm'])
    new_c = jnp.stack([s[0] for s in ss], axis=1)
    new_n = jnp.stack([s[1] for s in ss], axis=1)
    new_m = jnp.stack([s[2] for s in ss], axis=1)

    gates = jax.nn.sigmoid(mg.reshape(B, T, N_BRANCH, D_MODEL))
    merged = None
    for i, br in enumerate((y_ret, y_ssd, y_rw, y_ml)):
        term = gates[:, :, i] * (br.astype(h.dtype) @ lp['w_branch'][i])
        merged = term if merged is None else merged + term
    out = (merged @ lp['w_out']).astype(h.dtype)
    return out, (new_ret, new_ssd, new_rwkv, new_c, new_n, new_m)


def _conv_ffn(h, lp):
    u = _dwconv3(h @ lp['ffn_up'], lp['ffn_conv_w'], lp['ffn_conv_b'])
    val, gate = jnp.split(u, 2, axis=-1)
    return (val * jax.nn.silu(gate)) @ lp['ffn_down']


def _layer(x, mod, lp, state, rope):
    sh1, sc1, g1, sh2, sc2, g2 = (mod[:, i, None, :] for i in range(6))
    h = _rms(x, lp['norm1']) * (1.0 + sc1) + sh1
    mix, state = _mixer(h, lp, state, rope)
    x = x + g1 * mix
    h = _rms(x, lp['norm2']) * (1.0 + sc2) + sh2
    x = x + g2 * _conv_ffn(h, lp)
    return x, state


def _zero_states(b):
    def z(*s):
        return jnp.zeros((b, 2) + s, jnp.float32)
    return (z(RET_H, RET_DK, RET_DV), z(SSD_H, SSD_N, SSD_P), z(RWKV_H, RWKV_D, RWKV_D),
            z(ML_H, ML_DK, ML_DV), z(ML_H, ML_DK), z(ML_H))


def setup_inputs(seed: int = 0) -> dict:
    key = jax.random.key(seed)
    keys = iter(jax.random.split(key, 64))
    f32 = jnp.float32

    def nrm(shape, scale=1.0):
        return scale * jax.random.normal(next(keys), shape, f32)

    def unif(shape, lo, hi):
        return jax.random.uniform(next(keys), shape, f32, lo, hi)

    L, D, F, sb = DEPTH, D_MODEL, FFN_DIM, DEC_BATCH
    dt0 = jnp.exp(unif((L, 2, SSD_H), math.log(1e-3), math.log(1e-1)))
    return {
        'x_prompt': nrm((BATCH, SEQ, D)),
        'x_sample': nrm((DEC_BATCH, DEC_SEQ, D)),
        'state_ret': nrm((sb, L, 2, RET_H, RET_DK, RET_DV), 0.5),
        'state_ssd': nrm((sb, L, 2, SSD_H, SSD_N, SSD_P), 0.5),
        'state_rwkv': nrm((sb, L, 2, RWKV_H, RWKV_D, RWKV_D), 0.5),
        'state_mlstm_c': nrm((sb, L, 2, ML_H, ML_DK, ML_DV), 0.5),
        'state_mlstm_n': nrm((sb, L, 2, ML_H, ML_DK), 0.5),
        'state_mlstm_m': nrm((sb, L, 2, ML_H)),
        'c': nrm((sb, D)),
        'c_ctx': nrm((D,)),
        'ada_w': nrm((L, D, 6 * D), 0.5 * D ** -0.5),
        'ada_b': nrm((L, 6 * D), 0.02),
        'norm1': 1.0 + nrm((L, D), 0.02),
        'norm2': 1.0 + nrm((L, D), 0.02),
        'w_in': nrm((L, D, IN_DIM), D ** -0.5),
        'ret_log_rate': -(5.0 + jnp.arange(RET_H, dtype=f32)) * math.log(2.0) + nrm((L, 2, RET_H), 0.1),
        'ssd_conv_w': nrm((L, CONV_W, SSD_CONV_DIM), CONV_W ** -0.5),
        'ssd_conv_b': nrm((L, SSD_CONV_DIM), 0.02),
        'ssd_A_log': jnp.log(unif((L, 2, SSD_H), 1.0, 16.0)),
        'ssd_dt_bias': dt0 + jnp.log(-jnp.expm1(-dt0)),
        'ssd_D': 1.0 + nrm((L, 2, SSD_H), 0.1),
        'ssd_norm': 1.0 + nrm((L, MIX_W), 0.02),
        'rwkv_conv_w': nrm((L, CONV_W, 3 * MIX_W), CONV_W ** -0.5),
        'rwkv_w0': jnp.linspace(-6.0, -1.0, MIX_W, dtype=f32) + nrm((L, 2, MIX_W), 0.1),
        'rwkv_w_up': nrm((L, 2, RWKV_W_LORA, MIX_W), 0.1),
        'rwkv_a0': nrm((L, 2, MIX_W), 0.1),
        'rwkv_a_up': nrm((L, 2, RWKV_A_LORA, MIX_W), 0.5 * RWKV_A_LORA ** -0.5),
        'rwkv_g_up': nrm((L, RWKV_G_LORA, MIX_W), RWKV_G_LORA ** -0.5),
        'rwkv_k_k': 0.85 + nrm((L, MIX_W), 0.02),
        'rwkv_k_a': 1.0 + nrm((L, MIX_W), 0.02),
        'rwkv_r_k': nrm((L, MIX_W), 0.1),
        'rwkv_ln_w': 1.0 + nrm((L, MIX_W), 0.02),
        'rwkv_ln_b': nrm((L, MIX_W), 0.02),
        'ml_i_bias': nrm((L, 2, ML_H), 0.1) - 1.0,
        'ml_f_bias': jnp.linspace(3.0, 6.0, ML_H, dtype=f32) + nrm((L, 2, ML_H), 0.1),
        'ml_norm': 1.0 + nrm((L, MIX_W), 0.02),
        'w_branch': nrm((L, N_BRANCH, MIX_W, D), MIX_W ** -0.5),
        'w_out': nrm((L, D, D), D ** -0.5),
        'ffn_up': nrm((L, D, 2 * F), D ** -0.5),
        'ffn_conv_w': nrm((L, CONV_W, 2 * F), CONV_W ** -0.5),
        'ffn_conv_b': nrm((L, 2 * F), 0.02),
        'ffn_down': nrm((L, F, D), F ** -0.5),
        'final_norm': 1.0 + nrm((D,), 0.02),
    }


def reference(x_prompt, x_sample, state_ret, state_ssd, state_rwkv, state_mlstm_c, state_mlstm_n,
              state_mlstm_m, c, c_ctx, ada_w, ada_b, norm1, norm2, w_in, ret_log_rate, ssd_conv_w,
              ssd_conv_b, ssd_A_log, ssd_dt_bias, ssd_D, ssd_norm, rwkv_conv_w, rwkv_w0, rwkv_w_up,
              rwkv_a0, rwkv_a_up, rwkv_g_up, rwkv_k_k, rwkv_k_a, rwkv_r_k, rwkv_ln_w, rwkv_ln_b,
              ml_i_bias, ml_f_bias, ml_norm, w_branch, w_out, ffn_up, ffn_conv_w, ffn_conv_b,
              ffn_down, final_norm):
    rope = _grid_rope(x_sample.shape[1])
    xp, xs = x_prompt, x_sample
    ctx_states = []
    for l in range(DEPTH):
        lp = dict(norm1=norm1[l], norm2=norm2[l], w_in=w_in[l], ret_log_rate=ret_log_rate[l],
                  ssd_conv_w=ssd_conv_w[l], ssd_conv_b=ssd_conv_b[l], ssd_A_log=ssd_A_log[l],
                  ssd_dt_bias=ssd_dt_bias[l], ssd_D=ssd_D[l], ssd_norm=ssd_norm[l],
                  rwkv_conv_w=rwkv_conv_w[l], rwkv_w0=rwkv_w0[l], rwkv_w_up=rwkv_w_up[l],
                  rwkv_a0=rwkv_a0[l], rwkv_a_up=rwkv_a_up[l], rwkv_g_up=rwkv_g_up[l],
                  rwkv_k_k=rwkv_k_k[l], rwkv_k_a=rwkv_k_a[l], rwkv_r_k=rwkv_r_k[l],
                  rwkv_ln_w=rwkv_ln_w[l], rwkv_ln_b=rwkv_ln_b[l], ml_i_bias=ml_i_bias[l],
                  ml_f_bias=ml_f_bias[l], ml_norm=ml_norm[l], w_branch=w_branch[l], w_out=w_out[l],
                  ffn_up=ffn_up[l], ffn_conv_w=ffn_conv_w[l], ffn_conv_b=ffn_conv_b[l],
                  ffn_down=ffn_down[l])
        mod_ctx = (jax.nn.silu(c_ctx)[None] @ ada_w[l] + ada_b[l]).reshape(1, 6, D_MODEL)
        mod_lat = (jax.nn.silu(c) @ ada_w[l] + ada_b[l]).reshape(c.shape[0], 6, D_MODEL)
        xp, st = _layer(xp, mod_ctx, lp, _zero_states(xp.shape[0]), None)
        ctx_states.append(st)
        lat_init = (state_ret[:, l], state_ssd[:, l], state_rwkv[:, l],
                    state_mlstm_c[:, l], state_mlstm_n[:, l], state_mlstm_m[:, l])
        xs, _ = _layer(xs, mod_lat, lp, lat_init, rope)
    y_prompt = _rms(xp, final_norm)
    y_sample = _rms(xs, final_norm)
    new_ret = jnp.stack([s[0] for s in ctx_states], axis=1)
    new_ssd = jnp.stack([s[1] for s in ctx_states], axis=1)
    new_rwkv = jnp.stack([s[2] for s in ctx_states], axis=1)
    new_c = jnp.stack([s[3] for s in ctx_states], axis=1)
    new_n = jnp.stack([s[4] for s in ctx_states], axis=1)
    new_m = jnp.stack([s[5] for s in ctx_states], axis=1)
    return (y_prompt, y_sample, new_ret, new_ssd, new_rwkv, new_c, new_n, new_m)
```

```cpp
#include <hip/hip_runtime.h>
#include <hip/hip_cooperative_groups.h>
#include <cstdio>
#include <cstring>
namespace cg = cooperative_groups;

#ifndef RMASK
#define RMASK 0x000
#endif
#ifndef DUMPSEL
#define DUMPSEL 1
#endif
#ifndef DBGSTOP
#define DBGSTOP 0
#endif
#ifndef MEGA
#define MEGA 1
#endif

typedef unsigned short u16;
typedef __attribute__((ext_vector_type(8))) short bf16x8;
typedef __attribute__((ext_vector_type(4))) float f32x4;
typedef __attribute__((ext_vector_type(4))) unsigned u32x4;

#define DM 1024
#define GROWS 20480
#define PW 6272
#define C_RQ 0
#define C_RK 256
#define C_RV 512
#define C_RG 1024
#define C_SZ 1536
#define C_SX 2048
#define C_SB 2560
#define C_SC 2688
#define C_WR 2816
#define C_WK 3328
#define C_WV 3840
#define C_WW 4352
#define C_WA 4416
#define C_WG 4480
#define C_MQ 4608
#define C_MK 4864
#define C_MV 5120
#define C_MO 5632
#define C_DT 6144
#define C_IF 6160
#define WIN_ROWS 10368
#define FFN 2816

#define WS_CNT   0ull
#define WS_MOD   4096ull
#define WS_ROPE  (WS_MOD + 442368ull)
#define WS_BON   (WS_ROPE + 1048576ull)
#define WS_W     (WS_BON + 1310720ull)
#define W_WIN    0ull
#define W_WBR    (W_WIN + 21233664ull)
#define W_WOUT   (W_WBR + 4194304ull)
#define W_WUP    (W_WOUT + 2097152ull)
#define W_WDN    (W_WUP + 11534336ull)
#define W_WGU    (W_WDN + 5767168ull)
#define W_WWU    (W_WGU + 131072ull)
#define W_WAU    (W_WWU + 131072ull)
#define W_TOTAL  (W_WAU + 131072ull)
#define WS_H     (WS_W + W_TOTAL)
#define WS_P     (WS_H + 41943040ull)
#define WS_Y     (WS_P + 256901120ull)
#define WS_END   (WS_Y + 167772160ull)
#define WS_G     (WS_END + 16384ull + 36864ull)

#define O_Y      0ull
#define O_RET    41943040ull
#define O_SSD    (O_RET + 4194304ull)
#define O_RWKV   (O_SSD + 4194304ull)
#define O_C      (O_RWKV + 4194304ull)
#define O_N      (O_C + 4194304ull)
#define O_M      (O_N + 32768ull)

struct Params {
  const float* in[43];
  float* out;
  char* ws;
};

#define PP const __attribute__((address_space(4))) Params*
#define LAUNDER(p_) asm volatile("" : "+s"(p_))
enum { I_XP=0, I_XS, I_SRET, I_SSSD, I_SRWKV, I_SC, I_SN, I_SM, I_C, I_CCTX, I_ADAW, I_ADAB, I_N1, I_N2, I_WIN,
       I_RLR, I_SCW, I_SCB, I_SAL, I_SDTB, I_SD, I_SNORM, I_RCW, I_RW0, I_RWUP, I_RA0, I_RAUP, I_RGUP, I_RKK,
       I_RKA, I_RRK, I_RLNW, I_RLNB, I_MIB, I_MFB, I_MNORM, I_WBR, I_WOUT, I_FUP, I_FCW, I_FCB, I_FDN, I_FNORM };

__device__ __forceinline__ unsigned xb_ld(unsigned* p)              { return __hip_atomic_load(p, __ATOMIC_RELAXED, __HIP_MEMORY_SCOPE_AGENT); }
__device__ __forceinline__ unsigned xb_add(unsigned* p, unsigned v) { return __hip_atomic_fetch_add(p, v, __ATOMIC_RELAXED, __HIP_MEMORY_SCOPE_AGENT); }
__device__ __forceinline__ int ltid() { int t = __builtin_amdgcn_workitem_id_x(); asm volatile("" : "+v"(t)); return t; }
__device__ __forceinline__ u16 f2bf(float f) { unsigned u = __float_as_uint(f); u += 0x7fffu + ((u >> 16) & 1u); return (u16)(u >> 16); }
__device__ __forceinline__ float bf2f(u16 h) { return __uint_as_float(((unsigned)h) << 16); }
__device__ __forceinline__ float fexp_(float x) { return __builtin_amdgcn_exp2f(x * 1.4426950408889634f); }
__device__ __forceinline__ float flog_(float x) { return __builtin_amdgcn_logf(x) * 0.6931471805599453f; }
__device__ __forceinline__ float sigmoidf_(float x) { return __builtin_amdgcn_rcpf(1.f + fexp_(-x)); }
__device__ __forceinline__ float siluf_(float x) { return x * __builtin_amdgcn_rcpf(1.f + fexp_(-x)); }
__device__ __forceinline__ float softplusf_(float x) { return fmaxf(x, 0.f) + flog_(1.f + fexp_(-fabsf(x))); }
__device__ __forceinline__ float tanhf_(float x) { float e = fexp_(2.f * x); return 1.f - 2.f * __builtin_amdgcn_rcpf(e + 1.f); }

__device__ __forceinline__ void unpack8(const uint4& v, float* f) {
  f[0] = __uint_as_float(v.x << 16); f[1] = __uint_as_float(v.x & 0xffff0000u);
  f[2] = __uint_as_float(v.y << 16); f[3] = __uint_as_float(v.y & 0xffff0000u);
  f[4] = __uint_as_float(v.z << 16); f[5] = __uint_as_float(v.z & 0xffff0000u);
  f[6] = __uint_as_float(v.w << 16); f[7] = __uint_as_float(v.w & 0xffff0000u);
}
__device__ __forceinline__ uint4 pack8(const float* f) {
  uint4 v;
  v.x = (unsigned)f2bf(f[0]) | ((unsigned)f2bf(f[1]) << 16);
  v.y = (unsigned)f2bf(f[2]) | ((unsigned)f2bf(f[3]) << 16);
  v.z = (unsigned)f2bf(f[4]) | ((unsigned)f2bf(f[5]) << 16);
  v.w = (unsigned)f2bf(f[6]) | ((unsigned)f2bf(f[7]) << 16);
  return v;
}
__device__ __forceinline__ float wave_sum(float v) {
#pragma unroll
  for (int o = 32; o > 0; o >>= 1) v += __shfl_xor(v, o);
  return v;
}
__device__ __forceinline__ int swz(int row, int chunk) { return row * 64 + ((chunk ^ ((row >> 1) & 7)) << 3); }
__device__ __forceinline__ int sidx(int row, int col) { return row * 64 + ((((col >> 3) ^ ((row >> 1) & 7)) << 3) | (col & 7)); }

__device__ __forceinline__ void row_info(int grow, int& t, int& T, int& modi) {
  if (grow < 8192) { t = grow & 255; T = 256; modi = 0; }
  else { int r = grow - 8192; t = r & 4095; T = 4096; modi = 1 + (r >> 12); }
}

template <int WM, int WN, int ATR>
__device__ __forceinline__ void gemm_main(f32x4 (&acc)[WM][WN], const u16* __restrict__ A, size_t lda,
                                          const u16* __restrict__ Bt, size_t ldb, int K, u16* smem) {
  constexpr int BM = WM * 32, BN = WN * 32, ACH = BM / 32, BCH = BN / 32;
  u16* sA = smem;
  u16* sB = smem + 2 * BM * 64;
  int tid_ = ltid();
  const int tid = tid_, lane = tid & 63, wid = tid >> 6, wr = wid >> 1, wc = wid & 1;
  const int l15 = lane & 15, l4 = lane >> 4;
  u32x4 ra0[ACH], rb0[BCH], ra1[ACH], rb1[BCH];
  const int nk = K >> 6;
  const u16* Ap = A + (size_t)(tid >> 3) * lda + (tid & 7) * 8;
  const u16* Bp = Bt + (size_t)(tid >> 3) * ldb + (tid & 7) * 8;
#define GLOAD(ra_, rb_, kt_) do { const int ko_ = (kt_) * 64; \
    _Pragma("unroll") for (int i = 0; i < ACH; i++) ra_[i] = *(const u32x4*)(Ap + (size_t)(32 * i) * lda + ko_); \
    _Pragma("unroll") for (int i = 0; i < BCH; i++) rb_[i] = *(const u32x4*)(Bp + (size_t)(32 * i) * ldb + ko_); } while (0)
#define SSTORE(ra_, rb_, buf_) do { \
    _Pragma("unroll") for (int i = 0; i < ACH; i++) { \
      int idx = tid + 256 * i; u32x4 v = ra_[i]; \
      if (ATR == 1) { float f0, f1; \
        f0 = sigmoidf_(__uint_as_float(v.x << 16)); f1 = sigmoidf_(__uint_as_float(v.x & 0xffff0000u)); v.x = (unsigned)f2bf(f0) | ((unsigned)f2bf(f1) << 16); \
        f0 = sigmoidf_(__uint_as_float(v.y << 16)); f1 = sigmoidf_(__uint_as_float(v.y & 0xffff0000u)); v.y = (unsigned)f2bf(f0) | ((unsigned)f2bf(f1) << 16); \
        f0 = sigmoidf_(__uint_as_float(v.z << 16)); f1 = sigmoidf_(__uint_as_float(v.z & 0xffff0000u)); v.z = (unsigned)f2bf(f0) | ((unsigned)f2bf(f1) << 16); \
        f0 = sigmoidf_(__uint_as_float(v.w << 16)); f1 = sigmoidf_(__uint_as_float(v.w & 0xffff0000u)); v.w = (unsigned)f2bf(f0) | ((unsigned)f2bf(f1) << 16); } \
      *(u32x4*)(sA + (buf_) * BM * 64 + swz(idx >> 3, idx & 7)) = v; } \
    _Pragma("unroll") for (int i = 0; i < BCH; i++) { int idx = tid + 256 * i; *(u32x4*)(sB + (buf_) * BN * 64 + swz(idx >> 3, idx & 7)) = rb_[i]; } \
  } while (0)
#define COMPUTE(buf_) do { \
    const u16* a_ = sA + (buf_) * BM * 64; const u16* b_ = sB + (buf_) * BN * 64; \
    _Pragma("unroll") for (int ks = 0; ks < 2; ks++) { \
      bf16x8 af[WM], bfr[WN]; \
      _Pragma("unroll") for (int mi = 0; mi < WM; mi++) af[mi] = *(const bf16x8*)(a_ + swz(wr * WM * 16 + mi * 16 + l15, ks * 4 + l4)); \
      _Pragma("unroll") for (int ni = 0; ni < WN; ni++) bfr[ni] = *(const bf16x8*)(b_ + swz(wc * WN * 16 + ni * 16 + l15, ks * 4 + l4)); \
      _Pragma("unroll") for (int mi = 0; mi < WM; mi++) \
        _Pragma("unroll") for (int ni = 0; ni < WN; ni++) \
          acc[mi][ni] = __builtin_amdgcn_mfma_f32_16x16x32_bf16(af[mi], bfr[ni], acc[mi][ni], 0, 0, 0); } } while (0)
  GLOAD(ra0, rb0, 0);
  __syncthreads();
  SSTORE(ra0, rb0, 0);
  GLOAD(ra0, rb0, 1);
  if (nk > 2) GLOAD(ra1, rb1, 2);
  __syncthreads();
  for (int kt = 0; kt < nk; kt += 2) {
    COMPUTE(0);
    SSTORE(ra0, rb0, 1);
    if (kt + 3 < nk) GLOAD(ra0, rb0, kt + 3);
    __syncthreads();
    COMPUTE(1);
    if (kt + 2 < nk) SSTORE(ra1, rb1, 0);
    if (kt + 4 < nk) GLOAD(ra1, rb1, kt + 4);
    __syncthreads();
  }
#undef GLOAD
#undef SSTORE
#undef COMPUTE
}

template <int WM, int WN>
__device__ __forceinline__ void store_tile_bf16(f32x4 (&acc)[WM][WN], u16* smem, u16* C, size_t ldc) {
  constexpr int BM = WM * 32, BN = WN * 32, LD = BN + 8, CPR = BN / 8;
  int tid_ = ltid(); asm volatile("" : "+v"(tid_));
  const int tid = tid_, lane = tid & 63, wid = tid >> 6, wr = wid >> 1, wc = wid & 1;
  const int l15 = lane & 15, l4 = lane >> 4;
#pragma unroll
  for (int mi = 0; mi < WM; mi++)
#pragma unroll
    for (int ni = 0; ni < WN; ni++)
#pragma unroll
      for (int j = 0; j < 4; j++)
        smem[(wr * WM * 16 + mi * 16 + l4 * 4 + j) * LD + wc * WN * 16 + ni * 16 + l15] = f2bf(acc[mi][ni][j]);
  __syncthreads();
  for (int idx = tid; idx < BM * CPR; idx += 256) {
    int r = idx / CPR, c = idx % CPR;
    *(uint4*)(C + (size_t)r * ldc + c * 8) = *(const uint4*)(smem + r * LD + c * 8);
  }
}

template <int WM, int WN>
__device__ __forceinline__ void zero_acc(f32x4 (&acc)[WM][WN]) {
#pragma unroll
  for (int mi = 0; mi < WM; mi++)
#pragma unroll
    for (int ni = 0; ni < WN; ni++) acc[mi][ni] = f32x4{0.f, 0.f, 0.f, 0.f};
}

__device__ __forceinline__ void tile_mn(int id, int NT, int& m, int& n) {
  int per = 16 * NT; int mg = id / per; int r = id - mg * per; n = r >> 4; m = mg * 16 + (r & 15);
}

__device__ __forceinline__ void conv_weights(PP p, int l, u16* smem) {
  u16* W = (u16*)(p->ws + WS_W);
  const int tid = ltid();
  const int NTILES = 2592 + 512 + 256 + 1408 + 704 + 16 + 16 + 16;
  for (int tile = blockIdx.x; tile < NTILES; tile += gridDim.x) {
    const float* src; u16* dst; int K, N, ldsrc, tk, tn; int special = 0;
    int t = tile;
    if (t < 2592) { src = p->in[I_WIN] + (size_t)l * 1024 * 10272; ldsrc = 10272; K = 1024; N = WIN_ROWS; dst = W + W_WIN / 2; tk = t & 15; tn = t >> 4; special = 1; }
    else if ((t -= 2592) < 512) { int b = t >> 7; t &= 127; src = p->in[I_WBR] + ((size_t)l * 4 + b) * 512 * 1024; ldsrc = 1024; K = 512; N = 1024; dst = W + W_WBR / 2 + (size_t)b * 1024 * 512; tk = t & 7; tn = t >> 3; }
    else if ((t -= 512) < 256) { src = p->in[I_WOUT] + (size_t)l * 1024 * 1024; ldsrc = 1024; K = 1024; N = 1024; dst = W + W_WOUT / 2; tk = t & 15; tn = t >> 4; }
    else if ((t -= 256) < 1408) { src = p->in[I_FUP] + (size_t)l * 1024 * 5632; ldsrc = 5632; K = 1024; N = 5632; dst = W + W_WUP / 2; tk = t & 15; tn = t >> 4; }
    else if ((t -= 1408) < 704) { src = p->in[I_FDN] + (size_t)l * 2816 * 1024; ldsrc = 1024; K = 2816; N = 1024; dst = W + W_WDN / 2; tk = t % 44; tn = t / 44; }
    else if ((t -= 704) < 16) { src = p->in[I_RGUP] + (size_t)l * 128 * 512; ldsrc = 512; K = 128; N = 512; dst = W + W_WGU / 2; tk = t & 1; tn = t >> 1; }
    else if ((t -= 16) < 16) { int d = t >> 3; t &= 7; src = p->in[I_RWUP] + ((size_t)l * 2 + d) * 64 * 512; ldsrc = 512; K = 64; N = 512; dst = W + W_WWU / 2 + (size_t)d * 512 * 64; tk = 0; tn = t; }
    else { t -= 16; int d = t >> 3; t &= 7; src = p->in[I_RAUP] + ((size_t)l * 2 + d) * 64 * 512; ldsrc = 512; K = 64; N = 512; dst = W + W_WAU / 2 + (size_t)d * 512 * 64; tk = 0; tn = t; }
    __syncthreads();
    {
      int n = tn * 64 + (tid & 63);
      int on = n;
      if (special) {
        if (n < 2816) on = n; else if (n < 6144) on = n + 16; else if (n < 6160) on = 2816 + (n - 6144);
        else if (n < 6176) on = n; else if (n < 6272) on = -1; else on = 6176 + (n - 6272);
      }
#pragma unroll 4
      for (int i = 0; i < 16; i++) {
        int k = (tid >> 6) + i * 4;
        float v = (on >= 0) ? src[(size_t)(tk * 64 + k) * ldsrc + on] : 0.f;
        smem[(tid & 63) * 66 + k] = f2bf(v);
      }
    }
    __syncthreads();
    {
#pragma unroll
      for (int i = 0; i < 2; i++) {
        int idx = tid + 256 * i; int n = idx >> 3, c = idx & 7;
        const unsigned* sp = (const unsigned*)(smem + n * 66 + c * 8);
        uint4 v; v.x = sp[0]; v.y = sp[1]; v.z = sp[2]; v.w = sp[3];
        *(uint4*)(dst + (size_t)(tn * 64 + n) * K + tk * 64 + c * 8) = v;
      }
    }
  }
}

__device__ __forceinline__ void phase_prep(PP p, char* smem_raw) {
  const int tid = ltid();
  float* rc = (float*)(p->ws + WS_ROPE); float* rs = rc + 4096 * 32;
  for (int idx = blockIdx.x * 256 + tid; idx < 4096 * 32; idx += gridDim.x * 256) {
    int t = idx >> 5, j = idx & 31; int i = j & 15;
    float inv = exp2f(-(float)i * (13.287712379549449f / 16.f));
    float ang = (float)((j < 16) ? (t >> 6) : (t & 63)) * inv;
    float rev = ang * 0.15915494309189535f; rev -= floorf(rev);
    rc[idx] = __builtin_amdgcn_cosf(rev); rs[idx] = __builtin_amdgcn_sinf(rev);
  }
  float* sc = (float*)smem_raw;
  float* red = sc + 9 * 1024;
  float* mod = (float*)(p->ws + WS_MOD);
  for (int item = blockIdx.x; item < 192; item += gridDim.x) {
    int l = item / 96, cb = item % 96;
    __syncthreads();
    for (int i = tid; i < 9 * 1024; i += 256) {
      int v = i >> 10, k = i & 1023;
      float x = (v == 0) ? p->in[I_CCTX][k] : p->in[I_C][(v - 1) * 1024 + k];
      sc[i] = siluf_(x);
    }
    __syncthreads();
    int cl = tid & 63, kq = tid >> 6; int n = cb * 64 + cl;
    float acc[9];
#pragma unroll
    for (int v = 0; v < 9; v++) acc[v] = 0.f;
    const float* w = p->in[I_ADAW] + (size_t)l * 1024 * 6144 + n;
    for (int k = kq * 256; k < kq * 256 + 256; k++) {
      float wv = w[(size_t)k * 6144];
#pragma unroll
      for (int v = 0; v < 9; v++) acc[v] += sc[v * 1024 + k] * wv;
    }
#pragma unroll
    for (int v = 0; v < 9; v++) red[(kq * 9 + v) * 64 + cl] = acc[v];
    __syncthreads();
    for (int i = tid; i < 9 * 64; i += 256) {
      int v = i >> 6, c = i & 63;
      float s = red[(0 * 9 + v) * 64 + c] + red[(1 * 9 + v) * 64 + c] + red[(2 * 9 + v) * 64 + c] + red[(3 * 9 + v) * 64 + c];
      mod[((size_t)l * 9 + v) * 6144 + cb * 64 + c] = s + p->in[I_ADAB][(size_t)l * 6144 + cb * 64 + c];
    }
  }
  __syncthreads();
  conv_weights(p, 0, (u16*)smem_raw);
}

__device__ __forceinline__ void phase_norm(PP p, int l, int g, int which) {
  const int lane = ltid() & 63, wid = ltid() >> 6;
  const float* mod = (const float*)(p->ws + WS_MOD) + (size_t)l * 9 * 6144;
  const float* nw = p->in[which ? I_N2 : I_N1] + (size_t)l * 1024;
  u16* H = (u16*)(p->ws + WS_H);
  for (int rg = blockIdx.x * 4 + wid; rg < GROWS / 4; rg += gridDim.x * 4) {
    const int r0 = rg * 4;
    int grow = g * GROWS + r0; int t, T, mi; row_info(grow, t, T, mi);
    const float* x;
    if (l == 0 && which == 0) x = (grow < 8192) ? p->in[I_XP] + (size_t)grow * 1024 : p->in[I_XS] + (size_t)(grow - 8192) * 1024;
    else x = p->out + (size_t)grow * 1024;
    float4 v[4][4]; float ss[4];
#pragma unroll
    for (int k = 0; k < 4; k++)
#pragma unroll
      for (int i = 0; i < 4; i++) v[k][i] = *(const float4*)(x + k * 1024 + i * 256 + lane * 4);
#pragma unroll
    for (int k = 0; k < 4; k++) {
      float a_ = 0.f;
#pragma unroll
      for (int i = 0; i < 4; i++) a_ += v[k][i].x * v[k][i].x + v[k][i].y * v[k][i].y + v[k][i].z * v[k][i].z + v[k][i].w * v[k][i].w;
      ss[k] = a_;
    }
#pragma unroll
    for (int o = 32; o > 0; o >>= 1) {
#pragma unroll
      for (int k = 0; k < 4; k++) ss[k] += __shfl_xor(ss[k], o);
    }
    const float* sh = mod + (size_t)mi * 6144 + (which ? 3 : 0) * 1024;
    const float* sca = sh + 1024;
    float rinv[4];
#pragma unroll
    for (int k = 0; k < 4; k++) rinv[k] = rsqrtf(ss[k] * (1.f / 1024.f) + 1e-6f);
#pragma unroll
    for (int i = 0; i < 4; i++) {
      int c = i * 256 + lane * 4;
      float4 w4 = *(const float4*)(nw + c), s4 = *(const float4*)(sca + c), h4 = *(const float4*)(sh + c);
      float m0 = w4.x * (1.f + s4.x), m1 = w4.y * (1.f + s4.y), m2 = w4.z * (1.f + s4.z), m3 = w4.w * (1.f + s4.w);
#pragma unroll
      for (int k = 0; k < 4; k++) {
        float o0 = v[k][i].x * rinv[k] * m0 + h4.x;
        float o1 = v[k][i].y * rinv[k] * m1 + h4.y;
        float o2 = v[k][i].z * rinv[k] * m2 + h4.z;
        float o3 = v[k][i].w * rinv[k] * m3 + h4.w;
        uint2 o; o.x = (unsigned)f2bf(o0) | ((unsigned)f2bf(o1) << 16); o.y = (unsigned)f2bf(o2) | ((unsigned)f2bf(o3) << 16);
        *(uint2*)(H + (size_t)(r0 + k) * 1024 + c) = o;
      }
    }
  }
}

__device__ __forceinline__ void phase_gemm1(PP p, int l, int g, u16* smem) {
  const u16* H = (const u16*)(p->ws + WS_H);
  const u16* W = (const u16*)(p->ws + WS_W + W_WIN);
  u16* P = (u16*)(p->ws + WS_P);
  const float* rc = (const float*)(p->ws + WS_ROPE); const float* rs = rc + 4096 * 32;
  const int lane = ltid() & 63, wid = ltid() >> 6, wr = wid >> 1, wc = wid & 1, l15 = lane & 15, l4 = lane >> 4;
  const int NT = PW / 128;
  for (int id = blockIdx.x; id < 160 * NT; id += gridDim.x) {
    int m, n; tile_mn(id, NT, m, n);
    f32x4 acc[4][4]; zero_acc<4, 4>(acc);
    gemm_main<4, 4, 0>(acc, H + (size_t)m * 128 * 1024, 1024, W + (size_t)n * 128 * 1024, 1024, 1024, smem);
    const int col0 = n * 128 + wc * 64;
    if (col0 < 512) {
      const bool isq = col0 < 256;
#pragma unroll
      for (int mi = 0; mi < 4; mi++)
#pragma unroll
        for (int j = 0; j < 4; j++) {
          int grow = g * GROWS + m * 128 + wr * 64 + mi * 16 + l4 * 4 + j;
          if (grow >= 8192) {
            int t = (grow - 8192) & 4095;
#pragma unroll
            for (int ni = 0; ni < 2; ni++) {
              float c = rc[t * 32 + ni * 16 + l15], s = rs[t * 32 + ni * 16 + l15];
              float x1 = acc[mi][ni][j], x2 = acc[mi][ni + 2][j];
              acc[mi][ni][j] = x1 * c - x2 * s; acc[mi][ni + 2][j] = x1 * s + x2 * c;
            }
          }
          if (isq) {
#pragma unroll
            for (int ni = 0; ni < 4; ni++) acc[mi][ni][j] *= 0.125f;
          }
        }
    } else if (col0 >= C_MQ && col0 < C_MK) {
#pragma unroll
      for (int mi = 0; mi < 4; mi++)
#pragma unroll
        for (int ni = 0; ni < 4; ni++) acc[mi][ni] *= 0.125f;
    }
    store_tile_bf16<4, 4>(acc, smem, P + (size_t)m * 128 * PW + n * 128, PW);
  }
}

__device__ __forceinline__ void conv8_silu(const u16* prow, int t, int T, int col, const float* cw, const float* cb, int cidx, int cstride, float* out) {
  float xm[8], x0[8], xp[8];
  uint4 z = make_uint4(0, 0, 0, 0);
  uint4 vm = *(const uint4*)(prow - ((t > 0) ? PW : 0) + col);
  uint4 v0 = *(const uint4*)(prow + col);
  uint4 vp = *(const uint4*)(prow + ((t < T - 1) ? PW : 0) + col);
  if (!(t > 0)) vm = z;
  if (!(t < T - 1)) vp = z;
  unpack8(vm, xm); unpack8(v0, x0); unpack8(vp, xp);
#pragma unroll
  for (int e = 0; e < 8; e++) {
    float y = xm[e] * cw[cidx + e] + x0[e] * cw[cstride + cidx + e] + xp[e] * cw[2 * cstride + cidx + e];
    if (cb) { y += cb[cidx + e]; y = siluf_(y); }
    out[e] = y;
  }
}

__device__ __forceinline__ void conv8_rows(const uint4& vm, const uint4& v0, const uint4& vp, const float* cw, const float* cb, int cidx, int cstride, float* out) {
  float xm[8], x0[8], xp[8];
  unpack8(vm, xm); unpack8(v0, x0); unpack8(vp, xp);
#pragma unroll
  for (int e = 0; e < 8; e++) {
    float y = xm[e] * cw[cidx + e] + x0[e] * cw[cstride + cidx + e] + xp[e] * cw[2 * cstride + cidx + e];
    if (cb) { y += cb[cidx + e]; y = siluf_(y); }
    out[e] = y;
  }
}

template <int MIX>
__device__ __forceinline__ void chunk_scan(PP p, int l, int g, int seq, int head, int dir, char* smem_raw) {
  constexpr int NT = (MIX == 0) ? 8 : ((MIX == 1) ? 4 : 9);
  constexpr int VD = (MIX == 1) ? 64 : 128;
  u16* sQ = (u16*)smem_raw; u16* sK = sQ + 4096; u16* sKT = sK + 4096; u16* sATT = sKT + 4096;
  u16* sVT = sATT + 4096; u16* sST = sVT + 144 * 64;
  float* sF = (float*)(sST + 144 * 64);
  float* sRow = sF; float* sCol = sF + 64; float* sCoef = sF + 128; float* sTail = sF + 192; float* sFloor = sF + 256; float* sDt = sF + 320; float* sMisc = sF + 384; float* sCw = sF + 400;
  int tid_ = ltid(); asm volatile("" : "+v"(tid_));
  const int tid = tid_, lane = tid & 63, w = tid >> 6, l15 = lane & 15, l4 = lane >> 4;
  const bool lat = seq >= 32; const int b = seq - 32;
  const int T = lat ? 4096 : 256;
  const int lbase = (lat ? 8192 + b * 4096 : seq * 256) - g * GROWS;
  const u16* Pb = (const u16*)(p->ws + WS_P) + (size_t)lbase * PW;
  u16* Yd = (u16*)(p->ws + WS_Y) + ((size_t)dir * GROWS + lbase) * 2048 + ((MIX == 0) ? 0 : (MIX == 1 ? 512 : 1536)) + head * VD;
  const int HH = (MIX == 1) ? 8 : 4;
  const int pidx = (l * 2 + dir) * HH + head;
  float c1 = 0.f, c2 = 0.f;
  if (MIX == 0) c1 = -__expf(p->in[I_RLR][pidx]);
  if (MIX == 1) { c1 = -__expf(p->in[I_SAL][pidx]); c2 = p->in[I_SDTB][pidx]; }
  if (MIX == 2) { c1 = p->in[I_MIB][pidx]; c2 = p->in[I_MFB][pidx]; }
  const int qcol = (MIX == 0) ? C_RQ + head * 64 : ((MIX == 1) ? C_SC + (head >> 2) * 64 : C_MQ + head * 64);
  const int kcol = (MIX == 0) ? C_RK + head * 64 : ((MIX == 1) ? C_SB + (head >> 2) * 64 : C_MK + head * 64);
  const int vcol = (MIX == 0) ? C_RV + head * 128 : ((MIX == 1) ? C_SX + head * 64 : C_MV + head * 128);
  const float* scw = p->in[I_SCW] + (size_t)l * 3 * 768; const float* scb = p->in[I_SCB] + (size_t)l * 768;

  __syncthreads();
  if (MIX == 1) {
    for (int i = tid; i < 768; i += 256) {
      int grp = i / 192, c = i % 192, sub = c >> 6, cc = c & 63;
      int cb0 = (sub == 0) ? 640 + (head >> 2) * 64 : ((sub == 1) ? 512 + (head >> 2) * 64 : head * 64);
      sCw[i] = (grp < 3) ? scw[grp * 768 + cb0 + cc] : scb[cb0 + cc];
    }
  }
  f32x4 accS[NT];
  float mstate = 0.f;
#pragma unroll
  for (int ni = 0; ni < NT; ni++) accS[ni] = f32x4{0.f, 0.f, 0.f, 0.f};
  if (lat) {
    const size_t sb = (size_t)((b * 2 + l) * 2 + dir) * HH + head;
    const float* s0 = (MIX == 0) ? p->in[I_SRET] + sb * 64 * 128 : ((MIX == 1) ? p->in[I_SSSD] + sb * 64 * 64 : p->in[I_SC] + sb * 64 * 128);
#pragma unroll
    for (int ni = 0; ni < VD / 16; ni++)
#pragma unroll
      for (int j = 0; j < 4; j++) accS[ni][j] = s0[(size_t)(16 * w + l4 * 4 + j) * VD + ni * 16 + l15];
    if (MIX == 2) {
#pragma unroll
      for (int j = 0; j < 4; j++) accS[NT - 1][j] = (l15 == 0) ? p->in[I_SN][sb * 64 + 16 * w + l4 * 4 + j] : 0.f;
      mstate = p->in[I_SM][sb];
    }
  }
#pragma unroll
  for (int ni = 0; ni < NT; ni++) {
    uint2 o; o.x = (unsigned)f2bf(accS[ni][0]) | ((unsigned)f2bf(accS[ni][1]) << 16); o.y = (unsigned)f2bf(accS[ni][2]) | ((unsigned)f2bf(accS[ni][3]) << 16);
    *(uint2*)(sST + sidx(ni * 16 + l15, 16 * w + l4 * 4)) = o;
  }
  if (MIX == 2) { for (int i = tid; i < 16 * 64; i += 256) { int r = 128 + (i >> 6), c = i & 63; sVT[sidx(r, c)] = (r == 128) ? (u16)0x3F80 : (u16)0; } }

  const int nch = T >> 6;
  constexpr int NR = (MIX == 1) ? 3 : 1;
  constexpr int NVT = VD / 32;
  const int ptok = tid >> 2, ppart = tid & 3;
  u32x4 gq[2 * NR], gk[2 * NR], gv[NVT * NR];
  unsigned gs0 = 0, gs1 = 0;
  const u32x4 zz = {0u, 0u, 0u, 0u};
#define CS_LD3(dst_, i_, ptr_, t_) do { if (NR == 1) dst_[i_] = *(const u32x4*)(ptr_); else { \
      dst_[(i_) * NR] = *(const u32x4*)((ptr_) - (((t_) > 0) ? PW : 0)); dst_[(i_) * NR + 1] = *(const u32x4*)(ptr_); \
      dst_[(i_) * NR + NR - 1] = *(const u32x4*)((ptr_) + (((t_) < T - 1) ? PW : 0)); } } while (0)
#define CS_GLOAD(ci_) do { \
    { int pos_ = (ci_) * 64 + ptok; int t_ = dir ? (T - 1 - pos_) : pos_; const u16* pr_ = Pb + (size_t)t_ * PW; \
      _Pragma("unroll") for (int c_ = 0; c_ < 2; c_++) { CS_LD3(gq, c_, pr_ + qcol + (ppart * 2 + c_) * 8, t_); CS_LD3(gk, c_, pr_ + kcol + (ppart * 2 + c_) * 8, t_); } \
      _Pragma("unroll") for (int c_ = 0; c_ < NVT; c_++) { CS_LD3(gv, c_, pr_ + vcol + (ppart * NVT + c_) * 8, t_); } } \
    if (MIX != 0 && w == 0) { int pos_ = (ci_) * 64 + lane; int t_ = dir ? (T - 1 - pos_) : pos_; const u16* pr_ = Pb + (size_t)t_ * PW; \
      if (MIX == 1) gs0 = pr_[C_DT + dir * 8 + head]; else { gs0 = pr_[C_IF + dir * 8 + head]; gs1 = pr_[C_IF + dir * 8 + 4 + head]; } } \
  } while (0)
  CS_GLOAD(0);
  for (int ci = 0; ci < nch; ci++) {
    if (w == 0) {
      float lb, ib = 0.f;
      if (MIX == 0) lb = c1;
      else if (MIX == 1) { float dtv = softplusf_(bf2f((u16)gs0) + c2); sDt[lane] = dtv; lb = dtv * c1; }
      else { ib = bf2f((u16)gs0) + c1; lb = -softplusf_(-(bf2f((u16)gs1) + c2)); }
      float cs = lb;
#pragma unroll
      for (int o = 1; o < 64; o <<= 1) { float v = __shfl_up(cs, o); if (lane >= o) cs += v; }
      float cs63 = __shfl(cs, 63);
      if (MIX != 2) {
        sRow[lane] = cs; sCol[lane] = -cs; sCoef[lane] = fexp_(cs); sTail[lane] = fexp_(cs63 - cs);
        if (lane == 0) sMisc[0] = fexp_(cs63);
      } else {
        float gg = ib - cs; float pm = gg;
#pragma unroll
        for (int o = 1; o < 64; o <<= 1) { float v = __shfl_up(pm, o); if (lane >= o) pm = fmaxf(pm, v); }
        float M = fmaxf(mstate, pm); float M63 = __shfl(M, 63);
        sRow[lane] = -M; sCol[lane] = gg; sCoef[lane] = fexp_(mstate - M); sTail[lane] = fexp_(gg - M63); sFloor[lane] = fexp_(-cs - M);
        if (lane == 0) sMisc[0] = fexp_(mstate - M63);
        mstate = cs63 + M63;
      }
    }
    __syncthreads();
    {
      const float tl = sTail[ptok];
#pragma unroll
      for (int c = 0; c < 4; c++) {
        const int which = c >> 1, cc = c & 1, ch = ppart * 2 + cc;
        float f[8];
        u32x4 vq;
        if (MIX == 1) {
          const float* cwp = sCw + which * 64 + ch * 8;
          float xm[8], x0[8], xp[8];
          u32x4 r0 = which ? gk[cc * NR] : gq[cc * NR], r1 = which ? gk[cc * NR + 1] : gq[cc * NR + 1], r2 = which ? gk[cc * NR + NR - 1] : gq[cc * NR + NR - 1];
          { const int pos2 = ci * 64 + ptok; const int t2 = dir ? (T - 1 - pos2) : pos2; if (!(t2 > 0)) r0 = zz; if (!(t2 < T - 1)) r2 = zz; }
          uint4 t4; t4.x = r0.x; t4.y = r0.y; t4.z = r0.z; t4.w = r0.w; unpack8(t4, xm);
          t4.x = r1.x; t4.y = r1.y; t4.z = r1.z; t4.w = r1.w; unpack8(t4, x0);
          t4.x = r2.x; t4.y = r2.y; t4.z = r2.z; t4.w = r2.w; unpack8(t4, xp);
#pragma unroll
          for (int e = 0; e < 8; e++) f[e] = siluf_(xm[e] * cwp[e] + x0[e] * cwp[192 + e] + xp[e] * cwp[384 + e] + cwp[576 + e]);
          uint4 pk = pack8(f); vq.x = pk.x; vq.y = pk.y; vq.z = pk.z; vq.w = pk.w;
        } else {
          vq = which ? gk[cc] : gq[cc];
          uint4 t4; t4.x = vq.x; t4.y = vq.y; t4.z = vq.z; t4.w = vq.w; unpack8(t4, f);
        }
        if (which == 0) { *(u32x4*)(sQ + swz(ptok, ch)) = vq; }
        else {
          *(u32x4*)(sK + swz(ptok, ch)) = vq;
#pragma unroll
          for (int e = 0; e < 8; e++) sKT[sidx(ch * 8 + e, ptok)] = f2bf(f[e] * tl);
        }
        __builtin_amdgcn_sched_barrier(0);
      }
      float dtv = (MIX == 1) ? sDt[ptok] : 1.f;
#pragma unroll
      for (int c = 0; c < NVT; c++) {
        const int ch = ppart * NVT + c;
        float f[8];
        if (MIX == 1) {
          const float* cwp = sCw + 128 + ch * 8;
          float xm[8], x0[8], xp[8];
          u32x4 g0 = gv[c * NR], g2 = gv[c * NR + NR - 1];
          { const int pos2 = ci * 64 + ptok; const int t2 = dir ? (T - 1 - pos2) : pos2; if (!(t2 > 0)) g0 = zz; if (!(t2 < T - 1)) g2 = zz; }
          uint4 t4; t4.x = g0.x; t4.y = g0.y; t4.z = g0.z; t4.w = g0.w; unpack8(t4, xm);
          t4.x = gv[c * NR + 1].x; t4.y = gv[c * NR + 1].y; t4.z = gv[c * NR + 1].z; t4.w = gv[c * NR + 1].w; unpack8(t4, x0);
          t4.x = g2.x; t4.y = g2.y; t4.z = g2.z; t4.w = g2.w; unpack8(t4, xp);
#pragma unroll
          for (int e = 0; e < 8; e++) f[e] = dtv * siluf_(xm[e] * cwp[e] + x0[e] * cwp[192 + e] + xp[e] * cwp[384 + e] + cwp[576 + e]);
        } else {
          uint4 t4; t4.x = gv[c].x; t4.y = gv[c].y; t4.z = gv[c].z; t4.w = gv[c].w; unpack8(t4, f);
        }
#pragma unroll
        for (int e = 0; e < 8; e++) sVT[sidx(ch * 8 + e, ptok)] = f2bf(f[e]);
        __builtin_amdgcn_sched_barrier(0);
      }
    }
    __syncthreads();
    {
      f32x4 at[4];
#pragma unroll
      for (int ni = 0; ni < 4; ni++) at[ni] = f32x4{0.f, 0.f, 0.f, 0.f};
#pragma unroll
      for (int ks = 0; ks < 2; ks++) {
        bf16x8 a = *(const bf16x8*)(sQ + swz(16 * w + l15, ks * 4 + l4));
#pragma unroll
        for (int ni = 0; ni < 4; ni++) {
          bf16x8 bb = *(const bf16x8*)(sK + swz(16 * ni + l15, ks * 4 + l4));
          at[ni] = __builtin_amdgcn_mfma_f32_16x16x32_bf16(a, bb, at[ni], 0, 0, 0);
        }
      }
      float rw[4];
#pragma unroll
      for (int j = 0; j < 4; j++) rw[j] = sRow[16 * w + l4 * 4 + j];
#pragma unroll
      for (int ni = 0; ni < 4; ni++) {
        float cv = sCol[16 * ni + l15];
#pragma unroll
        for (int j = 0; j < 4; j++) {
          int r = 16 * w + l4 * 4 + j, c = 16 * ni + l15;
          float val = (c <= r) ? at[ni][j] * fexp_(rw[j] + cv) : 0.f;
          sATT[sidx(r, c)] = f2bf(val);
        }
      }
    }
    __syncthreads();
    {
      float cf[4], dv[4] = {1.f, 1.f, 1.f, 1.f};
#pragma unroll
      for (int j = 0; j < 4; j++) cf[j] = sCoef[16 * w + l4 * 4 + j];
      if (MIX == 2) {
        f32x4 ad = {0.f, 0.f, 0.f, 0.f};
#pragma unroll
        for (int ks = 0; ks < 2; ks++) {
          bf16x8 a = *(const bf16x8*)(sQ + swz(16 * w + l15, ks * 4 + l4));
          bf16x8 bb = *(const bf16x8*)(sST + swz(16 * 8 + l15, ks * 4 + l4));
          ad = __builtin_amdgcn_mfma_f32_16x16x32_bf16(a, bb, ad, 0, 0, 0);
        }
#pragma unroll
        for (int j = 0; j < 4; j++) ad[j] *= cf[j];
#pragma unroll
        for (int ks = 0; ks < 2; ks++) {
          bf16x8 a = *(const bf16x8*)(sATT + swz(16 * w + l15, ks * 4 + l4));
          bf16x8 bb = *(const bf16x8*)(sVT + swz(16 * 8 + l15, ks * 4 + l4));
          ad = __builtin_amdgcn_mfma_f32_16x16x32_bf16(a, bb, ad, 0, 0, 0);
        }
#pragma unroll
        for (int j = 0; j < 4; j++) {
          float den = __shfl(ad[j], lane & 48);
          dv[j] = __builtin_amdgcn_rcpf(fmaxf(fabsf(den), sFloor[16 * w + l4 * 4 + j]));
        }
      }
#pragma unroll 1
      for (int grp = 0; grp < VD / 64; grp++) {
        f32x4 ay[4];
#pragma unroll
        for (int ni = 0; ni < 4; ni++) ay[ni] = f32x4{0.f, 0.f, 0.f, 0.f};
#pragma unroll
        for (int ks = 0; ks < 2; ks++) {
          bf16x8 a = *(const bf16x8*)(sQ + swz(16 * w + l15, ks * 4 + l4));
#pragma unroll
          for (int ni = 0; ni < 4; ni++) {
            bf16x8 bb = *(const bf16x8*)(sST + swz(16 * (grp * 4 + ni) + l15, ks * 4 + l4));
            ay[ni] = __builtin_amdgcn_mfma_f32_16x16x32_bf16(a, bb, ay[ni], 0, 0, 0);
          }
        }
#pragma unroll
        for (int ni = 0; ni < 4; ni++)
#pragma unroll
          for (int j = 0; j < 4; j++) ay[ni][j] *= cf[j];
#pragma unroll
        for (int ks = 0; ks < 2; ks++) {
          bf16x8 a = *(const bf16x8*)(sATT + swz(16 * w + l15, ks * 4 + l4));
#pragma unroll
          for (int ni = 0; ni < 4; ni++) {
            bf16x8 bb = *(const bf16x8*)(sVT + swz(16 * (grp * 4 + ni) + l15, ks * 4 + l4));
            ay[ni] = __builtin_amdgcn_mfma_f32_16x16x32_bf16(a, bb, ay[ni], 0, 0, 0);
          }
        }
#pragma unroll
        for (int j = 0; j < 4; j++) {
          int pos = ci * 64 + 16 * w + l4 * 4 + j; int t = dir ? (T - 1 - pos) : pos;
          u16* yrow = Yd + (size_t)t * 2048 + grp * 64;
#pragma unroll
          for (int ni = 0; ni < 4; ni++) yrow[ni * 16 + l15] = f2bf(ay[ni][j] * dv[j]);
        }
      }
    }
    if (ci + 1 < nch) CS_GLOAD(ci + 1);
    __syncthreads();
    {
      float sc = sMisc[0];
#pragma unroll
      for (int ni = 0; ni < NT; ni++) accS[ni] *= sc;
#pragma unroll 1
      for (int ks = 0; ks < 2; ks++) {
        bf16x8 a = *(const bf16x8*)(sKT + swz(16 * w + l15, ks * 4 + l4));
#pragma unroll
        for (int ni = 0; ni < NT; ni++) {
          bf16x8 bb = *(const bf16x8*)(sVT + swz(16 * ni + l15, ks * 4 + l4));
          accS[ni] = __builtin_amdgcn_mfma_f32_16x16x32_bf16(a, bb, accS[ni], 0, 0, 0);
        }
      }
#pragma unroll
      for (int ni = 0; ni < NT; ni++) {
        uint2 o; o.x = (unsigned)f2bf(accS[ni][0]) | ((unsigned)f2bf(accS[ni][1]) << 16); o.y = (unsigned)f2bf(accS[ni][2]) | ((unsigned)f2bf(accS[ni][3]) << 16);
        *(uint2*)(sST + sidx(ni * 16 + l15, 16 * w + l4 * 4)) = o;
      }
    }
    __syncthreads();
  }
  if (!lat && !DBGSTOP) {
    const size_t sb = (size_t)((seq * 2 + l) * 2 + dir) * HH + head;
    float* o = p->out + ((MIX == 0) ? O_RET + sb * 64 * 128 : ((MIX == 1) ? O_SSD + sb * 64 * 64 : O_C + sb * 64 * 128));
#pragma unroll
    for (int ni = 0; ni < VD / 16; ni++)
#pragma unroll
      for (int j = 0; j < 4; j++) o[(size_t)(16 * w + l4 * 4 + j) * VD + ni * 16 + l15] = accS[ni][j];
    if (MIX == 2) {
      if (l15 == 0) {
#pragma unroll
        for (int j = 0; j < 4; j++) p->out[O_N + sb * 64 + 16 * w + l4 * 4 + j] = accS[NT - 1][j];
      }
      if (tid == 0) p->out[O_M + sb] = mstate;
    }
  }
}

typedef float f2v __attribute__((ext_vector_type(2)));
__device__ __forceinline__ float dpp_f(float x, const int ctrl_sel) {
  int xi = __float_as_int(x); int r;
  if (ctrl_sel == 0) r = __builtin_amdgcn_update_dpp(0, xi, 0xB1, 0xF, 0xF, true);
  else if (ctrl_sel == 1) r = __builtin_amdgcn_update_dpp(0, xi, 0x4E, 0xF, 0xF, true);
  else r = __builtin_amdgcn_update_dpp(0, xi, 0x141, 0xF, 0xF, true);
  return __int_as_float(r);
}
__device__ __forceinline__ float red8(float x) { x += dpp_f(x, 0); x += dpp_f(x, 1); x += dpp_f(x, 2); return x; }

struct RwOps { f2v w[4], a[4], b[4], k[4], r[4]; float v; };
#define RW_LOAD(o_, i_) do { const float* bs_ = sW + (i_) * 64 + ks * 8; \
    _Pragma("unroll") for (int q_ = 0; q_ < 4; q_++) { \
      o_.w[q_] = *(const f2v*)(bs_ + 2 * q_); o_.a[q_] = *(const f2v*)(bs_ + 2048 + 2 * q_); o_.b[q_] = *(const f2v*)(bs_ + 4096 + 2 * q_); \
      o_.k[q_] = *(const f2v*)(bs_ + 6144 + 2 * q_); o_.r[q_] = *(const f2v*)(bs_ + 8192 + 2 * q_); } \
    o_.v = sV[(i_) * 64 + vrow]; } while (0)

__device__ __forceinline__ void rwkv_scan(PP p, int l, int g, int seq, int head, int dir, int vhalf, char* smem_raw) {
  float* sW = (float*)smem_raw; float* sA = sW + 2048; float* sB = sA + 2048; float* sKD = sB + 2048; float* sR = sKD + 2048; float* sV = sR + 2048;
  u16* sWL = (u16*)(sV + 2048); u16* sAD = sWL + 2048;
  float* sY = (float*)sWL;
  u16* sUW = sAD + 2048; u16* sUA = sUW + 4096;
  float* sCst = (float*)(sUA + 4096);
  int tid_ = ltid(); asm volatile("" : "+v"(tid_));
  const int tid = tid_, lane = tid & 63, w = tid >> 6, l15 = lane & 15, l4 = lane >> 4;
  const bool lat = seq >= 32; const int b = seq - 32;
  const int T = lat ? 4096 : 256;
  const int lbase = (lat ? 8192 + b * 4096 : seq * 256) - g * GROWS;
  const u16* Pb = (const u16*)(p->ws + WS_P) + (size_t)lbase * PW;
  u16* Yd = (u16*)(p->ws + WS_Y) + ((size_t)dir * GROWS + lbase) * 2048 + 1024 + head * 64 + vhalf * 32;
  float* bon = (float*)(p->ws + WS_BON) + ((size_t)dir * GROWS + lbase) * 8 + head;
  const int hc = head * 64;
  const float* w0 = sCst + 576; const float* a0 = sCst + 640; const float* kkp = sCst + 704; const float* kap = sCst + 768; const float* rkp = sCst + 832;
  const int ks = lane & 7, rp = lane >> 3;
  const int vrow = vhalf * 32 + 8 * w + rp;

  __syncthreads();
  {
    const float* rcw = p->in[I_RCW] + (size_t)l * 3 * 1536;
    for (int i = tid; i < 576; i += 256) { int it = i / 192, tap = (i / 64) % 3, c = i & 63; sCst[i] = rcw[tap * 1536 + it * 512 + hc + c]; }
    if (tid < 64) {
      sCst[576 + tid] = p->in[I_RW0][(size_t)(l * 2 + dir) * 512 + hc + tid];
      sCst[640 + tid] = p->in[I_RA0][(size_t)(l * 2 + dir) * 512 + hc + tid];
      sCst[704 + tid] = p->in[I_RKK][(size_t)l * 512 + hc + tid];
      sCst[768 + tid] = p->in[I_RKA][(size_t)l * 512 + hc + tid];
      sCst[832 + tid] = p->in[I_RRK][(size_t)l * 512 + hc + tid];
    }
  }
  {
    const u16* uw = (const u16*)(p->ws + WS_W + W_WWU) + ((size_t)dir * 512 + hc) * 64;
    const u16* ua = (const u16*)(p->ws + WS_W + W_WAU) + ((size_t)dir * 512 + hc) * 64;
    for (int i = tid; i < 512; i += 256) {
      int r = i >> 3, c = i & 7;
      *(uint4*)(sUW + swz(r, c)) = *(const uint4*)(uw + r * 64 + c * 8);
      *(uint4*)(sUA + swz(r, c)) = *(const uint4*)(ua + r * 64 + c * 8);
    }
  }
  f2v S[4];
#pragma unroll
  for (int e = 0; e < 4; e++) S[e] = f2v{0.f, 0.f};
  if (lat) {
    const float* s0 = p->in[I_SRWKV] + ((size_t)((b * 2 + l) * 2 + dir) * 8 + head) * 4096 + (size_t)vrow * 64 + ks * 8;
#pragma unroll
    for (int e = 0; e < 4; e++) S[e] = *(const f2v*)(s0 + 2 * e);
  }
  const int ptok = tid >> 3, pch = tid & 7;
  u32x4 gl[2], gc[9];
  const u32x4 zz = {0u, 0u, 0u, 0u};
#define RW_GLOAD(ci_) do { \
    { int pos_ = (ci_) * 32 + ptok; int t_ = dir ? (T - 1 - pos_) : pos_; const u16* pr_ = Pb + (size_t)t_ * PW; \
      gl[0] = *(const u32x4*)(pr_ + C_WW + pch * 8); gl[1] = *(const u32x4*)(pr_ + C_WA + pch * 8); \
      _Pragma("unroll") for (int it_ = 0; it_ < 3; it_++) { const u16* q_ = pr_ + C_WR + it_ * 512 + hc + pch * 8; \
        gc[it_ * 3 + 0] = *(const u32x4*)(q_ - ((t_ > 0) ? PW : 0)); gc[it_ * 3 + 1] = *(const u32x4*)(q_); \
        gc[it_ * 3 + 2] = *(const u32x4*)(q_ + ((t_ < T - 1) ? PW : 0)); } } } while (0)
  RW_GLOAD(0);
  const int nsub = T >> 5;
  for (int ci = 0; ci < nsub; ci++) {
    __syncthreads();
    {
      float f[8];
      { uint4 v; v.x = gl[0].x; v.y = gl[0].y; v.z = gl[0].z; v.w = gl[0].w; unpack8(v, f);
#pragma unroll
        for (int e = 0; e < 8; e++) f[e] = tanhf_(f[e]);
        *(uint4*)(sWL + swz(ptok, pch)) = pack8(f);
        uint4 v2; v2.x = gl[1].x; v2.y = gl[1].y; v2.z = gl[1].z; v2.w = gl[1].w;
        *(uint4*)(sAD + swz(ptok, pch)) = v2; }
#pragma unroll
      for (int it = 0; it < 3; it++) {
        float xm[8], x0[8], xp[8];
        const int pos1 = ci * 32 + ptok; const int t1 = dir ? (T - 1 - pos1) : pos1;
        const u32x4 gm = (t1 > 0) ? gc[it * 3] : zz, gp = (t1 < T - 1) ? gc[it * 3 + 2] : zz;
        uint4 v; v.x = gm.x; v.y = gm.y; v.z = gm.z; v.w = gm.w; unpack8(v, xm);
        v.x = gc[it * 3 + 1].x; v.y = gc[it * 3 + 1].y; v.z = gc[it * 3 + 1].z; v.w = gc[it * 3 + 1].w; unpack8(v, x0);
        v.x = gp.x; v.y = gp.y; v.z = gp.z; v.w = gp.w; unpack8(v, xp);
        const float* cw = sCst + it * 192 + pch * 8;
#pragma unroll
        for (int e = 0; e < 8; e++) f[e] = xm[e] * cw[e] + x0[e] * cw[64 + e] + xp[e] * cw[128 + e];
        float* dst = (it == 0) ? sR : ((it == 1) ? sKD : sV);
        *(float4*)(dst + ptok * 64 + pch * 8) = make_float4(f[0], f[1], f[2], f[3]);
        *(float4*)(dst + ptok * 64 + pch * 8 + 4) = make_float4(f[4], f[5], f[6], f[7]);
      }
    }
    __syncthreads();
    {
#pragma unroll
      for (int mi = 0; mi < 2; mi++) {
        f32x4 aw = {0.f, 0.f, 0.f, 0.f}, aa = {0.f, 0.f, 0.f, 0.f};
#pragma unroll
        for (int k2 = 0; k2 < 2; k2++) {
          bf16x8 x1 = *(const bf16x8*)(sWL + swz(mi * 16 + l15, k2 * 4 + l4));
          bf16x8 y1 = *(const bf16x8*)(sUW + swz(16 * w + l15, k2 * 4 + l4));
          aw = __builtin_amdgcn_mfma_f32_16x16x32_bf16(x1, y1, aw, 0, 0, 0);
          bf16x8 x2 = *(const bf16x8*)(sAD + swz(mi * 16 + l15, k2 * 4 + l4));
          bf16x8 y2 = *(const bf16x8*)(sUA + swz(16 * w + l15, k2 * 4 + l4));
          aa = __builtin_amdgcn_mfma_f32_16x16x32_bf16(x2, y2, aa, 0, 0, 0);
        }
#pragma unroll
        for (int j = 0; j < 4; j++) { int tok = mi * 16 + l4 * 4 + j; sW[tok * 64 + 16 * w + l15] = aw[j]; sB[tok * 64 + 16 * w + l15] = aa[j]; }
      }
    }
    __syncthreads();
    {
      int tok = tid >> 3, cg8 = (tid & 7) * 8;
      const int base = tok * 64 + cg8;
      float kraw[8], kkv[8], pwv[8], pav[8], rr[8], cK[8], cW[8], cA[8], cKa[8], cRk[8], n2 = 0.f, bs = 0.f;
      *(float4*)&kraw[0] = *(const float4*)(sKD + base); *(float4*)&kraw[4] = *(const float4*)(sKD + base + 4);
      *(float4*)&pwv[0] = *(const float4*)(sW + base); *(float4*)&pwv[4] = *(const float4*)(sW + base + 4);
      *(float4*)&pav[0] = *(const float4*)(sB + base); *(float4*)&pav[4] = *(const float4*)(sB + base + 4);
      *(float4*)&rr[0] = *(const float4*)(sR + base); *(float4*)&rr[4] = *(const float4*)(sR + base + 4);
      *(float4*)&cK[0] = *(const float4*)(kkp + cg8); *(float4*)&cK[4] = *(const float4*)(kkp + cg8 + 4);
      *(float4*)&cW[0] = *(const float4*)(w0 + cg8); *(float4*)&cW[4] = *(const float4*)(w0 + cg8 + 4);
      *(float4*)&cA[0] = *(const float4*)(a0 + cg8); *(float4*)&cA[4] = *(const float4*)(a0 + cg8 + 4);
      *(float4*)&cKa[0] = *(const float4*)(kap + cg8); *(float4*)&cKa[4] = *(const float4*)(kap + cg8 + 4);
      *(float4*)&cRk[0] = *(const float4*)(rkp + cg8); *(float4*)&cRk[4] = *(const float4*)(rkp + cg8 + 4);
#pragma unroll
      for (int e = 0; e < 8; e++) { kkv[e] = kraw[e] * cK[e]; n2 += kkv[e] * kkv[e]; }
      n2 = red8(n2);
      float inv = __builtin_amdgcn_rsqf(fmaxf(n2, 1e-24f));
      float oW[8], oA[8], oB[8], oK[8];
#pragma unroll
      for (int e = 0; e < 8; e++) {
        float pw = cW[e] + pwv[e];
        float dec = __builtin_amdgcn_exp2f(-0.8750388f * sigmoidf_(pw));
        float ic = sigmoidf_(cA[e] + pav[e]);
        float kk = kkv[e] * inv;
        float kd = kraw[e] * (1.f + (ic - 1.f) * cKa[e]);
        oW[e] = dec; oA[e] = -kk; oB[e] = kk * ic; oK[e] = kd;
        bs += rr[e] * kd * cRk[e];
      }
      *(float4*)(sW + base) = *(const float4*)&oW[0]; *(float4*)(sW + base + 4) = *(const float4*)&oW[4];
      *(float4*)(sA + base) = *(const float4*)&oA[0]; *(float4*)(sA + base + 4) = *(const float4*)&oA[4];
      *(float4*)(sB + base) = *(const float4*)&oB[0]; *(float4*)(sB + base + 4) = *(const float4*)&oB[4];
      *(float4*)(sKD + base) = *(const float4*)&oK[0]; *(float4*)(sKD + base + 4) = *(const float4*)&oK[4];
      bs = red8(bs);
      if ((tid & 7) == 0 && vhalf == 0) { int pos = ci * 32 + tok; int t = dir ? (T - 1 - pos) : pos; bon[(size_t)t * 8] = bs; }
    }
    __syncthreads();
    if (ci + 1 < nsub) RW_GLOAD(ci + 1);
    {
      RwOps cur, nxt;
      RW_LOAD(cur, 0);
#pragma unroll 1
      for (int o = 0; o < 4; o++) {
        float yk = 0.f;
#pragma unroll
        for (int ii = 0; ii < 8; ii++) {
          const int i = o * 8 + ii;
          if (i + 1 < 32) RW_LOAD(nxt, i + 1);
          f2v acc = S[0] * cur.a[0];
          acc = S[1] * cur.a[1] + acc; acc = S[2] * cur.a[2] + acc; acc = S[3] * cur.a[3] + acc;
          float sa = red8(acc.x + acc.y);
          f2v sa2 = f2v{sa, sa}, v2 = f2v{cur.v, cur.v};
          f2v y2 = f2v{0.f, 0.f};
#pragma unroll
          for (int e = 0; e < 4; e++) {
            f2v t2 = sa2 * cur.b[e] + v2 * cur.k[e];
            S[e] = S[e] * cur.w[e] + t2;
            y2 = S[e] * cur.r[e] + y2;
          }
          float y = red8(y2.x + y2.y);
          yk = (ks == ii) ? y : yk;
          cur = nxt;
          __builtin_amdgcn_sched_barrier(0);
        }
        sY[(8 * o + ks) * 32 + 8 * w + rp] = yk;
      }
    }
    __syncthreads();
    {
      int tok = tid >> 3, c4 = (tid & 7) * 4;
      int pos = ci * 32 + tok; int t = dir ? (T - 1 - pos) : pos;
      float4 yv = *(const float4*)(sY + tok * 32 + c4);
      uint2 o; o.x = (unsigned)f2bf(yv.x) | ((unsigned)f2bf(yv.y) << 16); o.y = (unsigned)f2bf(yv.z) | ((unsigned)f2bf(yv.w) << 16);
      *(uint2*)(Yd + (size_t)t * 2048 + c4) = o;
    }
  }
  if (!lat && !DBGSTOP) {
    float* o = p->out + O_RWKV + ((size_t)((seq * 2 + l) * 2 + dir) * 8 + head) * 4096 + (size_t)vrow * 64 + ks * 8;
#pragma unroll
    for (int e = 0; e < 4; e++) *(f2v*)(o + 2 * e) = S[e];
  }
}

__device__ __forceinline__ void ggemm_tile(PP p, u16* smem, int id) {
  const u16* P = (const u16*)(p->ws + WS_P);
  const u16* W = (const u16*)(p->ws + WS_W + W_WGU);
  u16* G = (u16*)(p->ws + WS_G);
  int m = id >> 2, n = id & 3;
  f32x4 acc[4][4]; zero_acc<4, 4>(acc);
  gemm_main<4, 4, 1>(acc, P + (size_t)m * 128 * PW + C_WG, PW, W + (size_t)n * 128 * 128, 128, 128, smem);
  store_tile_bf16<4, 4>(acc, smem, G + (size_t)m * 128 * 512 + n * 128, 512);
}

template <int MASK>
__device__ __forceinline__ void post_row(PP p, int l, int g, int r, int lane) {
  const u16* P = (const u16*)(p->ws + WS_P);
  u16* Y = (u16*)(p->ws + WS_Y);
  const float* bon = (const float*)(p->ws + WS_BON);
  const int c0 = lane * 8;
  {
    int grow = g * GROWS + r; int t, T, mi; row_info(grow, t, T, mi);
    const u16* prow = P + (size_t)r * PW;
    u16* y0p = Y + (size_t)r * 2048; const u16* y1p = Y + ((size_t)GROWS + r) * 2048;
    const u16* prm = prow - ((t > 0) ? PW : 0); const u16* prp = prow + ((t < T - 1) ? PW : 0);
    uint4 Ly0[4], Ly1[4];
#pragma unroll
    for (int k = 0; k < 4; k++) { Ly0[k] = *(const uint4*)(y0p + k * 512 + c0); Ly1[k] = *(const uint4*)(y1p + k * 512 + c0); }
    const uint4 Lrg = *(const uint4*)(prow + C_RG + c0), Lsz = *(const uint4*)(prow + C_SZ + c0), Lg = *(const uint4*)((const u16*)(p->ws + WS_G) + (size_t)r * 512 + c0), Lmo = *(const uint4*)(prow + C_MO + c0);
    uint4 Sx0 = *(const uint4*)(prm + C_SX + c0), Sx1 = *(const uint4*)(prow + C_SX + c0), Sx2 = *(const uint4*)(prp + C_SX + c0);
    uint4 Wv0 = *(const uint4*)(prm + C_WV + c0), Wv1 = *(const uint4*)(prow + C_WV + c0), Wv2 = *(const uint4*)(prp + C_WV + c0);
    const float bsum = bon[(size_t)r * 8 + (lane >> 3)] + bon[((size_t)GROWS + r) * 8 + (lane >> 3)];
    { const uint4 z4 = make_uint4(0, 0, 0, 0); if (!(t > 0)) { Sx0 = z4; Wv0 = z4; } if (!(t < T - 1)) { Sx2 = z4; Wv2 = z4; } }
    float a[8], bq[8], s[8], o[8], gt[8];
    if (MASK & 1) { unpack8(Ly0[0], a); unpack8(Ly1[0], bq);
      float sm = 0.f, sq = 0.f;
#pragma unroll
      for (int e = 0; e < 8; e++) { s[e] = a[e] + bq[e]; sm += s[e]; sq += s[e] * s[e]; }
#pragma unroll
      for (int x = 1; x < 16; x <<= 1) { sm += __shfl_xor(sm, x); sq += __shfl_xor(sq, x); }
      float mu = sm * (1.f / 128.f); float var = fmaxf(sq * (1.f / 128.f) - mu * mu, 0.f); float ri = rsqrtf(var + 1e-5f);
      unpack8(Lrg, gt);
#pragma unroll
      for (int e = 0; e < 8; e++) o[e] = siluf_(gt[e]) * (s[e] - mu) * ri;
      *(uint4*)(y0p + c0) = pack8(o); }
    if (MASK & 1) { unpack8(Ly0[1], a); unpack8(Ly1[1], bq);
      float xs[8];
      conv8_rows(Sx0, Sx1, Sx2, p->in[I_SCW] + (size_t)l * 3 * 768, p->in[I_SCB] + (size_t)l * 768, c0, 768, xs);
      int h = lane >> 3;
      float dsum = p->in[I_SD][(l * 2 + 0) * 8 + h] + p->in[I_SD][(l * 2 + 1) * 8 + h];
      unpack8(Lsz, gt);
      float sq = 0.f;
#pragma unroll
      for (int e = 0; e < 8; e++) { s[e] = (a[e] + bq[e] + dsum * xs[e]) * siluf_(gt[e]); sq += s[e] * s[e]; }
      sq = wave_sum(sq);
      float ri = rsqrtf(sq * (1.f / 512.f) + 1e-6f);
      const float* nw = p->in[I_SNORM] + (size_t)l * 512 + c0;
#pragma unroll
      for (int e = 0; e < 8; e++) o[e] = s[e] * ri * nw[e];
      *(uint4*)(y0p + 512 + c0) = pack8(o); }
    if (MASK & 2) { unpack8(Ly0[2], a); unpack8(Ly1[2], bq);
      float sm = 0.f, sq = 0.f;
#pragma unroll
      for (int e = 0; e < 8; e++) { s[e] = a[e] + bq[e]; sm += s[e]; sq += s[e] * s[e]; }
#pragma unroll
      for (int x = 1; x < 8; x <<= 1) { sm += __shfl_xor(sm, x); sq += __shfl_xor(sq, x); }
      float mu = sm * (1.f / 64.f); float var = fmaxf(sq * (1.f / 64.f) - mu * mu, 0.f); float ri = rsqrtf(var + 64e-5f);
      float vv[8];
      conv8_rows(Wv0, Wv1, Wv2, p->in[I_RCW] + (size_t)l * 3 * 1536, nullptr, 1024 + c0, 1536, vv);
      unpack8(Lg, gt);
      const float* lw = p->in[I_RLNW] + (size_t)l * 512 + c0; const float* lbp = p->in[I_RLNB] + (size_t)l * 512 + c0;
#pragma unroll
      for (int e = 0; e < 8; e++) o[e] = ((s[e] - mu) * ri * lw[e] + lbp[e] + bsum * vv[e]) * gt[e];
      *(uint4*)(y0p + 1024 + c0) = pack8(o); }
    if (MASK & 1) { unpack8(Ly0[3], a); unpack8(Ly1[3], bq);
      float sm = 0.f, sq = 0.f;
#pragma unroll
      for (int e = 0; e < 8; e++) { s[e] = a[e] + bq[e]; sm += s[e]; sq += s[e] * s[e]; }
#pragma unroll
      for (int x = 1; x < 16; x <<= 1) { sm += __shfl_xor(sm, x); sq += __shfl_xor(sq, x); }
      float mu = sm * (1.f / 128.f); float var = fmaxf(sq * (1.f / 128.f) - mu * mu, 0.f); float ri = rsqrtf(var + 1e-5f);
      unpack8(Lmo, gt);
      const float* nw = p->in[I_MNORM] + (size_t)l * 512 + c0;
#pragma unroll
      for (int e = 0; e < 8; e++) o[e] = sigmoidf_(gt[e]) * (s[e] - mu) * ri * nw[e];
      *(uint4*)(y0p + 1536 + c0) = pack8(o); }
  }
}

__device__ __forceinline__ void phase_post(PP p, int l, int g) {
  const int lane = ltid() & 63, wid = ltid() >> 6;
  for (int r = blockIdx.x * 4 + wid; r < GROWS; r += gridDim.x * 4) post_row<2>(p, l, g, r, lane);
}

__device__ __forceinline__ void phase_scans(PP p, int l, int g, int cnt_idx, char* smem_raw, const unsigned* st) {
  __shared__ int s_item;
  const int nlat = g ? 5 : 3, lat0 = g ? 3 : 0, nctx = g ? 0 : 32;
  const unsigned slot = st[2], rwcu = st[3];
  const int tid = ltid();
  if (rwcu) {
    if (slot != 0) return;
    int* cnt = (int*)(p->ws + WS_CNT) + cnt_idx * 8;
    const int r0 = nlat * 32, r1 = r0 + nctx * 32;
    while (true) {
      __syncthreads();
      if (tid == 0) s_item = atomicAdd(cnt, 1);
      __syncthreads();
      const int it = __builtin_amdgcn_readfirstlane(s_item);
      if (it >= r1) break;
      LAUNDER(p);
      int seq, j;
      if (it < r0) { seq = 32 + lat0 + it / 32; j = it % 32; }
      else { int q = it - r0; seq = q / 32; j = q % 32; }
      rwkv_scan(p, l, g, seq, (j >> 1) & 7, j & 1, j >> 4, smem_raw);
    }
  } else {
    int* cnt = (int*)(p->ws + WS_CNT) + cnt_idx * 8 + 1;
    const int c0 = nlat * 32, c1 = c0 + nctx * 32;
    int nproc = 0;
    while (true) {
      __syncthreads();
      if (tid == 0) s_item = atomicAdd(cnt, 1);
      __syncthreads();
      const int it = __builtin_amdgcn_readfirstlane(s_item);
      if (it >= c1) break;
      LAUNDER(p);
      int seq, j;
      if (it < c0) { seq = 32 + lat0 + it / 32; j = it % 32; }
      else { int q = it - c0; seq = q / 32; j = q % 32; }
      if (j < 8) chunk_scan<2>(p, l, g, seq, j >> 1, j & 1, smem_raw);
      else if (j < 16) chunk_scan<0>(p, l, g, seq, (j - 8) >> 1, j & 1, smem_raw);
      else chunk_scan<1>(p, l, g, seq, (j - 16) >> 1, j & 1, smem_raw);
      nproc++;
    }
    {
      int* gq = (int*)(p->ws + WS_CNT) + cnt_idx * 8 + 4;
      while (true) {
        __syncthreads();
        if (tid == 0) s_item = atomicAdd(gq, 1);
        __syncthreads();
        const int id = __builtin_amdgcn_readfirstlane(s_item);
        if (id >= 160 * 4) break;
        LAUNDER(p);
        ggemm_tile(p, (u16*)smem_raw, id);
      }
    }
    asm volatile("s_waitcnt vmcnt(0)" ::: "memory");
    __syncthreads();
    if (tid == 0) {
      unsigned* done = (unsigned*)(p->ws + WS_CNT) + cnt_idx * 8 + 2;
      __builtin_amdgcn_fence(__ATOMIC_RELEASE, "agent");
      asm volatile("s_waitcnt vmcnt(0)" ::: "memory");
      (void)xb_add(done, (unsigned)nproc);
      unsigned sp = 0u;
      while (xb_ld(done) < (unsigned)c1) { __builtin_amdgcn_s_sleep(2); if (++sp > (1u << 25)) break; }
      __builtin_amdgcn_fence(__ATOMIC_ACQUIRE, "agent");
      asm volatile("s_waitcnt vmcnt(0)" ::: "memory");
    }
    __syncthreads();
    {
      int* rowq = (int*)(p->ws + WS_CNT) + cnt_idx * 8 + 3;
      const int lane = tid & 63, wid = tid >> 6;
      while (true) {
        __syncthreads();
        if (tid == 0) s_item = atomicAdd(rowq, 1);
        __syncthreads();
        const int rg = __builtin_amdgcn_readfirstlane(s_item);
        if (rg >= GROWS / 16) break;
        LAUNDER(p);
#pragma unroll 1
        for (int k = 0; k < 4; k++) post_row<1>(p, l, g, rg * 16 + wid * 4 + k, lane);
      }
    }
  }
}


__device__ __forceinline__ void phase_merge(PP p, u16* smem) {
  const u16* H = (const u16*)(p->ws + WS_H);
  const u16* Y = (const u16*)(p->ws + WS_Y);
  u16* M = (u16*)(p->ws + WS_Y) + (size_t)GROWS * 2048;
  const u16* WG = (const u16*)(p->ws + WS_W + W_WIN) + (size_t)PW * 1024;
  const u16* WB = (const u16*)(p->ws + WS_W + W_WBR);
  for (int id = blockIdx.x; id < 160 * 16; id += gridDim.x) {
    int m, n; tile_mn(id, 16, m, n);
    f32x4 mg[4][2]; zero_acc<4, 2>(mg);
#pragma unroll 1
    for (int b = 0; b < 4; b++) {
      f32x4 ag[4][2]; zero_acc<4, 2>(ag);
      gemm_main<4, 2, 0>(ag, H + (size_t)m * 128 * 1024, 1024, WG + ((size_t)b * 1024 + n * 64) * 1024, 1024, 1024, smem);
#pragma unroll
      for (int mi = 0; mi < 4; mi++)
#pragma unroll
        for (int ni = 0; ni < 2; ni++)
#pragma unroll
          for (int j = 0; j < 4; j++) ag[mi][ni][j] = sigmoidf_(ag[mi][ni][j]);
      f32x4 ay[4][2]; zero_acc<4, 2>(ay);
      gemm_main<4, 2, 0>(ay, Y + (size_t)m * 128 * 2048 + b * 512, 2048, WB + ((size_t)b * 1024 + n * 64) * 512, 512, 512, smem);
#pragma unroll
      for (int mi = 0; mi < 4; mi++)
#pragma unroll
        for (int ni = 0; ni < 2; ni++) mg[mi][ni] += ag[mi][ni] * ay[mi][ni];
    }
    store_tile_bf16<4, 2>(mg, smem, M + (size_t)m * 128 * 1024 + n * 64, 1024);
  }
}

__device__ __forceinline__ void phase_resgemm(PP p, int l, int g, int which, u16* smem) {
  const u16* A; size_t lda; int K; const u16* W;
  if (which == 0) { A = (const u16*)(p->ws + WS_Y) + (size_t)GROWS * 2048; lda = 1024; K = 1024; W = (const u16*)(p->ws + WS_W + W_WOUT); }
  else { A = (const u16*)(p->ws + WS_Y); lda = FFN; K = FFN; W = (const u16*)(p->ws + WS_W + W_WDN); }
  const float* mod = (const float*)(p->ws + WS_MOD) + (size_t)l * 9 * 6144 + (which ? 5 : 2) * 1024;
  const int lane = ltid() & 63, wid = ltid() >> 6, wr = wid >> 1, wc = wid & 1, l15 = lane & 15, l4 = lane >> 4;
  for (int id = blockIdx.x; id < 160 * 8; id += gridDim.x) {
    int m, n; tile_mn(id, 8, m, n);
    f32x4 acc[4][4]; zero_acc<4, 4>(acc);
    gemm_main<4, 4, 0>(acc, A + (size_t)m * 128 * lda, lda, W + (size_t)n * 128 * K, K, K, smem);
#pragma unroll
    for (int mi = 0; mi < 4; mi++)
#pragma unroll
      for (int j = 0; j < 4; j++) {
        int grow = g * GROWS + m * 128 + wr * 64 + mi * 16 + l4 * 4 + j;
        int t, T, modi; row_info(grow, t, T, modi);
        const float* xin;
        if (l == 0 && which == 0) xin = (grow < 8192) ? p->in[I_XP] + (size_t)grow * 1024 : p->in[I_XS] + (size_t)(grow - 8192) * 1024;
        else xin = p->out + (size_t)grow * 1024;
        float* xo = p->out + (size_t)grow * 1024;
        const float* gp = mod + (size_t)modi * 6144;
#pragma unroll
        for (int ni = 0; ni < 4; ni++) {
          int c = n * 128 + wc * 64 + ni * 16 + l15;
          xo[c] = xin[c] + gp[c] * acc[mi][ni][j];
        }
      }
  }
}

__device__ __forceinline__ void phase_ffnup(PP p, u16* smem) {
  const u16* H = (const u16*)(p->ws + WS_H);
  const u16* W = (const u16*)(p->ws + WS_W + W_WUP);
  u16* U = (u16*)(p->ws + WS_P);
  for (int id = blockIdx.x; id < 160 * 44; id += gridDim.x) {
    int m, n; tile_mn(id, 44, m, n);
    f32x4 acc[4][4]; zero_acc<4, 4>(acc);
    gemm_main<4, 4, 0>(acc, H + (size_t)m * 128 * 1024, 1024, W + (size_t)n * 128 * 1024, 1024, 1024, smem);
    store_tile_bf16<4, 4>(acc, smem, U + (size_t)m * 128 * 5632 + n * 128, 5632);
  }
}

__device__ __forceinline__ void phase_act(PP p, int l, int g) {
  const u16* U = (const u16*)(p->ws + WS_P);
  u16* ACT = (u16*)(p->ws + WS_Y);
  const float* cw = p->in[I_FCW] + (size_t)l * 3 * 5632; const float* cb = p->in[I_FCB] + (size_t)l * 5632;
  const int total = (GROWS / 4) * 352;
  for (int idx = blockIdx.x * 256 + ltid(); idx < total; idx += gridDim.x * 256) {
    const int rb = idx / 352, cc = (idx - rb * 352) * 8, r0 = rb * 4;
    int t0, T, mi; row_info(g * GROWS + r0, t0, T, mi);
    const u16* u0 = U + (size_t)r0 * 5632 + cc;
    const bool hasp = t0 > 0, hasn = t0 + 4 < T;
    uint4 va[6], vg[6];
#pragma unroll
    for (int k = 0; k < 6; k++) {
      int off = k - 1; if (k == 0 && !hasp) off = 0; if (k == 5 && !hasn) off = 3;
      va[k] = *(const uint4*)(u0 + (ptrdiff_t)off * 5632); vg[k] = *(const uint4*)(u0 + (ptrdiff_t)off * 5632 + FFN);
    }
    const uint4 z = make_uint4(0, 0, 0, 0);
    if (!hasp) { va[0] = z; vg[0] = z; }
    if (!hasn) { va[5] = z; vg[5] = z; }
    float wv[3][8], wg[3][8], bv[8], bg[8];
#pragma unroll
    for (int k = 0; k < 3; k++) {
      *(float4*)&wv[k][0] = *(const float4*)(cw + k * 5632 + cc); *(float4*)&wv[k][4] = *(const float4*)(cw + k * 5632 + cc + 4);
      *(float4*)&wg[k][0] = *(const float4*)(cw + k * 5632 + FFN + cc); *(float4*)&wg[k][4] = *(const float4*)(cw + k * 5632 + FFN + cc + 4);
    }
    *(float4*)&bv[0] = *(const float4*)(cb + cc); *(float4*)&bv[4] = *(const float4*)(cb + cc + 4);
    *(float4*)&bg[0] = *(const float4*)(cb + FFN + cc); *(float4*)&bg[4] = *(const float4*)(cb + FFN + cc + 4);
    float pm[8], p0[8], gm[8], g0[8];
    unpack8(va[0], pm); unpack8(va[1], p0); unpack8(vg[0], gm); unpack8(vg[1], g0);
#pragma unroll
    for (int k = 0; k < 4; k++) {
      float pp[8], gp[8], o[8];
      unpack8(va[k + 2], pp); unpack8(vg[k + 2], gp);
#pragma unroll
      for (int e = 0; e < 8; e++) {
        float val = pm[e] * wv[0][e] + p0[e] * wv[1][e] + pp[e] * wv[2][e] + bv[e];
        float gt = gm[e] * wg[0][e] + g0[e] * wg[1][e] + gp[e] * wg[2][e] + bg[e];
        o[e] = val * siluf_(gt);
        pm[e] = p0[e]; p0[e] = pp[e]; gm[e] = g0[e]; g0[e] = gp[e];
      }
      *(uint4*)(ACT + (size_t)(r0 + k) * FFN + cc) = pack8(o);
    }
  }
}

__device__ __forceinline__ void phase_final(PP p) {
  const int lane = ltid() & 63, wid = ltid() >> 6;
  const float* nw = p->in[I_FNORM];
  for (int rg = blockIdx.x * 4 + wid; rg < 2 * GROWS / 4; rg += gridDim.x * 4) {
    float* x = p->out + (size_t)rg * 4 * 1024;
    float4 v[4][4]; float ss[4];
#pragma unroll
    for (int k = 0; k < 4; k++)
#pragma unroll
      for (int i = 0; i < 4; i++) v[k][i] = *(const float4*)(x + k * 1024 + i * 256 + lane * 4);
#pragma unroll
    for (int k = 0; k < 4; k++) {
      float a_ = 0.f;
#pragma unroll
      for (int i = 0; i < 4; i++) a_ += v[k][i].x * v[k][i].x + v[k][i].y * v[k][i].y + v[k][i].z * v[k][i].z + v[k][i].w * v[k][i].w;
      ss[k] = a_;
    }
#pragma unroll
    for (int o = 32; o > 0; o >>= 1) {
#pragma unroll
      for (int k = 0; k < 4; k++) ss[k] += __shfl_xor(ss[k], o);
    }
#pragma unroll
    for (int i = 0; i < 4; i++) {
      int c = i * 256 + lane * 4; float4 w4 = *(const float4*)(nw + c);
#pragma unroll
      for (int k = 0; k < 4; k++) {
        float rinv = rsqrtf(ss[k] * (1.f / 1024.f) + 1e-6f);
        float4 o = make_float4(v[k][i].x * rinv * w4.x, v[k][i].y * rinv * w4.y, v[k][i].z * rinv * w4.z, v[k][i].w * rinv * w4.w);
        *(float4*)(x + k * 1024 + c) = o;
      }
    }
  }
}

__device__ __forceinline__ void phase_dump(PP p) {
  const u16* Y = (const u16*)(p->ws + WS_Y);
  const float* bon = (const float*)(p->ws + WS_BON);
  for (size_t i = (size_t)blockIdx.x * 256 + ltid(); i < (size_t)2 * GROWS * 1024; i += (size_t)gridDim.x * 256) {
    float v = 0.f;
    if (i < (size_t)GROWS * 2048) { int col = (int)(i & 2047); bool isr = (col >= 1024 && col < 1536); if (isr == (DUMPSEL != 0)) v = bf2f(Y[i]) + 2.f * bf2f(Y[i + (size_t)GROWS * 2048]); }
    if (DUMPSEL && i < (size_t)2 * GROWS * 8) v += bon[i];
    p->out[i] = v;
  }
}

#define WS_BAR   WS_END
#define WS_CU    (WS_END + 16384ull)
#define XB_TMO      128
#define XB_XCNT(j)  (256  + 64 * (j))
#define XB_XSUB(j)  (1280 + 64 * (j))
#define XB_XGEN(j)  (2304 + 64 * (j))
#define XB_TOP      3328
#define XB_TOPGEN   3392
#define XCD_BAR_WORDS 3456
#define XB_SPIN_CAP (1u << 25)
__device__ __forceinline__ unsigned xb_xcc_id() { return (unsigned)__builtin_amdgcn_s_getreg((3 << 11) | 20) & 0xFu; }
#define XB_SPIN(cond, bar) do { unsigned _sp = 0; while (cond) { __builtin_amdgcn_s_sleep(1); \
    if ((++_sp & 255u) == 0u) { if (xb_ld(&(bar)[XB_TMO])) break; if (_sp > XB_SPIN_CAP) { atomicAdd(&(bar)[XB_TMO], 1u); break; } } } } while (0)
__device__ __forceinline__ void xcd_barrier_complete(unsigned* bar, unsigned x, unsigned& nloc, unsigned& nx) {
  const unsigned G = gridDim.x;
  unsigned sum, cnt, mine, sp = 0u;
  for (;;) {
    sum = 0u; cnt = 0u; mine = 0u;
#pragma unroll
    for (unsigned j = 0; j < 16; ++j) { const unsigned c = xb_ld(&bar[XB_XCNT(j)]); sum += c; cnt += (c > 0u) ? 1u : 0u; mine = (j == x) ? c : mine; }
    if (sum == G) break;
    __builtin_amdgcn_s_sleep(1);
    if ((++sp & 255u) == 0u) { if (xb_ld(&bar[XB_TMO])) break; if (sp > XB_SPIN_CAP) { atomicAdd(&bar[XB_TMO], 1u); break; } }
  }
  nloc = mine > 0u ? mine : 1u; nx = cnt > 0u ? cnt : 1u;
}
__device__ __forceinline__ void xcd_barrier(unsigned* bar, volatile unsigned* st) {
  asm volatile("s_waitcnt vmcnt(0)" ::: "memory");
  __syncthreads();
  if (ltid() == 0) {
    const unsigned x = xb_xcc_id();
    __builtin_amdgcn_s_waitcnt(0);
    unsigned nloc = st[0], nx = st[1];
    if (nloc == 0u) { xcd_barrier_complete(bar, x, nloc, nx); st[0] = nloc; st[1] = nx; }
    const unsigned old = xb_add(&bar[XB_XSUB(x)], 1u);
    const unsigned gen = old / nloc;
    if (old + 1u == (gen + 1u) * nloc) {
      __builtin_amdgcn_fence(__ATOMIC_RELEASE, "agent");
      asm volatile("s_waitcnt vmcnt(0)" ::: "memory");
      const unsigned og = xb_add(&bar[XB_TOP], 1u);
      const unsigned tg = og / nx;
      if (og + 1u == (tg + 1u) * nx) xb_add(&bar[XB_TOPGEN], 1u);
      else XB_SPIN(xb_ld(&bar[XB_TOPGEN]) == tg, bar);
      __builtin_amdgcn_fence(__ATOMIC_ACQUIRE, "agent");
      xb_add(&bar[XB_XGEN(x)], 1u);
      asm volatile("s_waitcnt vmcnt(0)" ::: "memory");
    } else {
      XB_SPIN(xb_ld(&bar[XB_XGEN(x)]) == gen, bar);
      __builtin_amdgcn_fence(__ATOMIC_ACQUIRE, "agent");
      asm volatile("s_waitcnt vmcnt(0)" ::: "memory");
    }
  }
  __syncthreads();
}

#define NPHASES 42
#ifndef DBGSTOP
#define DBGSTOP 0
#endif
#ifndef PMASK
#define PMASK 0xFFFF
#endif
__global__ void __launch_bounds__(256, 2) mega(Params pval, int lo, int hi) {
  __shared__ __attribute__((aligned(16))) char smem_raw[77824];
  __shared__ __attribute__((aligned(16))) unsigned xb_st[4];
  unsigned* xbar = (unsigned*)(((PP)__builtin_amdgcn_kernarg_segment_ptr())->ws + WS_BAR);
  if (ltid() < 4) xb_st[ltid()] = 0u;
  __syncthreads();
  if (ltid() == 0) {
    (void)xb_add(&xbar[XB_XCNT(xb_xcc_id())], 1u);
    unsigned* cu = (unsigned*)(((PP)__builtin_amdgcn_kernarg_segment_ptr())->ws + WS_CU);
    const unsigned hw = (unsigned)__builtin_amdgcn_s_getreg((31 << 11) | 4);
    const unsigned key = (xb_xcc_id() << 8) | ((hw >> 8) & 0xFFu);
    const unsigned slot = xb_add(&cu[key], 1u);
    unsigned rank = 0u;
    if (slot == 0u) { rank = xb_add(&cu[8192], 1u); __hip_atomic_store(&cu[4096 + key], rank + 1u, __ATOMIC_RELAXED, __HIP_MEMORY_SCOPE_AGENT); }
    (void)xb_add(&cu[8193], 1u);
    { unsigned sp = 0u; while (xb_ld(&cu[8193]) < gridDim.x) { __builtin_amdgcn_s_sleep(2); if (++sp > (1u << 24)) break; } }
    if (slot != 0u) { unsigned r = 0u, sp = 0u; while ((r = xb_ld(&cu[4096 + key])) == 0u) { __builtin_amdgcn_s_sleep(2); if (++sp > (1u << 24)) break; } rank = (r > 0u) ? r - 1u : 0xFFFFu; }
    const unsigned ncu = xb_ld(&cu[8192]);
    unsigned nr = (ncu * 5u) / 8u; if (nr > 160u) nr = 160u;
    xb_st[2] = slot; xb_st[3] = (rank < nr) ? 1u : 0u;
  }
  __syncthreads();
  for (int ph = lo; ph < hi; ph++) {
    if (ph > lo) {
      if (ph == lo + 1) cg::this_grid().sync();
      else xcd_barrier((unsigned*)(((PP)__builtin_amdgcn_kernarg_segment_ptr())->ws + WS_BAR), xb_st);
    }
    PP p = (PP)__builtin_amdgcn_kernarg_segment_ptr();
    LAUNDER(p);
    if (ph == 0) { phase_prep(p, smem_raw); continue; }
    if (ph == NPHASES - 1) { phase_final(p); continue; }
    int q = ph - 1; int lg = q / 10, st = q % 10; int l = lg >> 1, g = lg & 1;
    switch (st) {
      case 0: phase_norm(p, l, g, 0); if (l == 1 && g == 0) conv_weights(p, 1, (u16*)smem_raw); break;
      case 1: phase_gemm1(p, l, g, (u16*)smem_raw); break;
      case 2: phase_scans(p, l, g, ph, smem_raw, xb_st); break;
      case 3: phase_post(p, l, g); break;
      case 4: phase_merge(p, (u16*)smem_raw); break;
      case 5: phase_resgemm(p, l, g, 0, (u16*)smem_raw); break;
      case 6: phase_norm(p, l, g, 1); break;
      case 7: phase_ffnup(p, (u16*)smem_raw); break;
      case 8: phase_act(p, l, g); break;
      case 9: phase_resgemm(p, l, g, 1, (u16*)smem_raw); break;
    }
  }
}

extern "C" void kernel_launch(void* const* d_in, const int* in_sizes, int n_in, void* d_out, int out_size,
                              void* d_ws, size_t ws_size, hipStream_t stream) {
  static int grid_blocks = 0;
  if (!grid_blocks) {
    int dev = 0, cus = 0, per_cu = 0;
    hipGetDevice(&dev);
    hipDeviceGetAttribute(&cus, hipDeviceAttributeMultiprocessorCount, dev);
    hipOccupancyMaxActiveBlocksPerMultiprocessor(&per_cu, mega, 256, 0);
    if (per_cu < 1) per_cu = 1;
    if (per_cu > 2) per_cu = 2;
    grid_blocks = cus * per_cu;
  }
  Params p;
  memset(&p, 0, sizeof(p));
  for (int i = 0; i < 43; i++) p.in[i] = (const float*)d_in[i];
  p.out = (float*)d_out;
  p.ws = (char*)d_ws;
  if (ws_size < WS_G + (size_t)GROWS * 1024) { fprintf(stderr, "workspace too small: %zu < %llu\n", ws_size, (unsigned long long)WS_END); return; }
  hipMemsetAsync(d_ws, 0, 4096, stream);
  hipMemsetAsync((char*)d_ws + WS_BAR, 0, 16384 + 36864, stream);
#if MEGA
  int lo = 0, hi = (DBGSTOP > 0) ? DBGSTOP + 1 : NPHASES;
  void* args[] = {&p, &lo, &hi};
  hipError_t e = hipLaunchCooperativeKernel((void*)mega, dim3(grid_blocks), dim3(256), args, 0, stream);
  if (e != hipSuccess) fprintf(stderr, "cooperative launch failed: %s (grid %d)\n", hipGetErrorString(e), grid_blocks);
#else
  for (int ph = 0; ph < NPHASES; ph++) mega<<<grid_blocks, 256, 0, stream>>>(p, ph, ph + 1);
#endif
}
```

```cpp
#include <hip/hip_runtime.h>
#include <hip/hip_cooperative_groups.h>
#include <cstdio>
#include <cstring>
namespace cg = cooperative_groups;

#ifndef RMASK
#define RMASK 0x000
#endif
#ifndef DUMPSEL
#define DUMPSEL 1
#endif
#ifndef DBGSTOP
#define DBGSTOP 0
#endif
#ifndef MEGA
#define MEGA 1
#endif

typedef unsigned short u16;
typedef __attribute__((ext_vector_type(8))) short bf16x8;
typedef __attribute__((ext_vector_type(4))) float f32x4;
typedef __attribute__((ext_vector_type(4))) unsigned u32x4;

#define DM 1024
#define GROWS 20480
#define PW 6272
#define C_RQ 0
#define C_RK 256
#define C_RV 512
#define C_RG 1024
#define C_SZ 1536
#define C_SX 2048
#define C_SB 2560
#define C_SC 2688
#define C_WR 2816
#define C_WK 3328
#define C_WV 3840
#define C_WW 4352
#define C_WA 4416
#define C_WG 4480
#define C_MQ 4608
#define C_MK 4864
#define C_MV 5120
#define C_MO 5632
#define C_DT 6144
#define C_IF 6160
#define WIN_ROWS 10368
#define FFN 2816

#define WS_CNT   0ull
#define WS_MOD   4096ull
#define WS_ROPE  (WS_MOD + 442368ull)
#define WS_BON   (WS_ROPE + 1048576ull)
#define WS_W     (WS_BON + 1310720ull)
#define W_WIN    0ull
#define W_WBR    (W_WIN + 21233664ull)
#define W_WOUT   (W_WBR + 4194304ull)
#define W_WUP    (W_WOUT + 2097152ull)
#define W_WDN    (W_WUP + 11534336ull)
#define W_WGU    (W_WDN + 5767168ull)
#define W_WWU    (W_WGU + 131072ull)
#define W_WAU    (W_WWU + 131072ull)
#define W_TOTAL  (W_WAU + 131072ull)
#define WS_H     (WS_W + W_TOTAL)
#define WS_P     (WS_H + 41943040ull)
#define WS_Y     (WS_P + 256901120ull)
#define WS_END   (WS_Y + 167772160ull)
#define WS_G     (WS_END + 16384ull + 36864ull)

#define O_Y      0ull
#define O_RET    41943040ull
#define O_SSD    (O_RET + 4194304ull)
#define O_RWKV   (O_SSD + 4194304ull)
#define O_C      (O_RWKV + 4194304ull)
#define O_N      (O_C + 4194304ull)
#define O_M      (O_N + 32768ull)

struct Params {
  const float* in[43];
  float* out;
  char* ws;
};

#define PP const __attribute__((address_space(4))) Params*
#define LAUNDER(p_) asm volatile("" : "+s"(p_))
enum { I_XP=0, I_XS, I_SRET, I_SSSD, I_SRWKV, I_SC, I_SN, I_SM, I_C, I_CCTX, I_ADAW, I_ADAB, I_N1, I_N2, I_WIN,
       I_RLR, I_SCW, I_SCB, I_SAL, I_SDTB, I_SD, I_SNORM, I_RCW, I_RW0, I_RWUP, I_RA0, I_RAUP, I_RGUP, I_RKK,
       I_RKA, I_RRK, I_RLNW, I_RLNB, I_MIB, I_MFB, I_MNORM, I_WBR, I_WOUT, I_FUP, I_FCW, I_FCB, I_FDN, I_FNORM };

__device__ __forceinline__ unsigned xb_ld(unsigned* p)              { return __hip_atomic_load(p, __ATOMIC_RELAXED, __HIP_MEMORY_SCOPE_AGENT); }
__device__ __forceinline__ unsigned xb_add(unsigned* p, unsigned v) { return __hip_atomic_fetch_add(p, v, __ATOMIC_RELAXED, __HIP_MEMORY_SCOPE_AGENT); }
__device__ __forceinline__ int ltid() { int t = __builtin_amdgcn_workitem_id_x(); asm volatile("" : "+v"(t)); return t; }
__device__ __forceinline__ u16 f2bf(float f) { unsigned u = __float_as_uint(f); u += 0x7fffu + ((u >> 16) & 1u); return (u16)(u >> 16); }
__device__ __forceinline__ float bf2f(u16 h) { return __uint_as_float(((unsigned)h) << 16); }
__device__ __forceinline__ float fexp_(float x) { return __builtin_amdgcn_exp2f(x * 1.4426950408889634f); }
__device__ __forceinline__ float flog_(float x) { return __builtin_amdgcn_logf(x) * 0.6931471805599453f; }
__device__ __forceinline__ float sigmoidf_(float x) { return __builtin_amdgcn_rcpf(1.f + fexp_(-x)); }
__device__ __forceinline__ float siluf_(float x) { return x * __builtin_amdgcn_rcpf(1.f + fexp_(-x)); }
__device__ __forceinline__ float softplusf_(float x) { return fmaxf(x, 0.f) + flog_(1.f + fexp_(-fabsf(x))); }
__device__ __forceinline__ float tanhf_(float x) { float e = fexp_(2.f * x); return 1.f - 2.f * __builtin_amdgcn_rcpf(e + 1.f); }

__device__ __forceinline__ void unpack8(const uint4& v, float* f) {
  f[0] = __uint_as_float(v.x << 16); f[1] = __uint_as_float(v.x & 0xffff0000u);
  f[2] = __uint_as_float(v.y << 16); f[3] = __uint_as_float(v.y & 0xffff0000u);
  f[4] = __uint_as_float(v.z << 16); f[5] = __uint_as_float(v.z & 0xffff0000u);
  f[6] = __uint_as_float(v.w << 16); f[7] = __uint_as_float(v.w & 0xffff0000u);
}
__device__ __forceinline__ uint4 pack8(const float* f) {
  uint4 v;
  v.x = (unsigned)f2bf(f[0]) | ((unsigned)f2bf(f[1]) << 16);
  v.y = (unsigned)f2bf(f[2]) | ((unsigned)f2bf(f[3]) << 16);
  v.z = (unsigned)f2bf(f[4]) | ((unsigned)f2bf(f[5]) << 16);
  v.w = (unsigned)f2bf(f[6]) | ((unsigned)f2bf(f[7]) << 16);
  return v;
}
__device__ __forceinline__ float wave_sum(float v) {
#pragma unroll
  for (int o = 32; o > 0; o >>= 1) v += __shfl_xor(v, o);
  return v;
}
__device__ __forceinline__ int swz(int row, int chunk) { return row * 64 + ((chunk ^ ((row >> 1) & 7)) << 3); }
__device__ __forceinline__ int sidx(int row, int col) { return row * 64 + ((((col >> 3) ^ ((row >> 1) & 7)) << 3) | (col & 7)); }

__device__ __forceinline__ void row_info(int grow, int& t, int& T, int& modi) {
  if (grow < 8192) { t = grow & 255; T = 256; modi = 0; }
  else { int r = grow - 8192; t = r & 4095; T = 4096; modi = 1 + (r >> 12); }
}

template <int WM, int WN, int ATR>
__device__ __forceinline__ void gemm_main(f32x4 (&acc)[WM][WN], const u16* __restrict__ A, size_t lda,
                                          const u16* __restrict__ Bt, size_t ldb, int K, u16* smem) {
  constexpr int BM = WM * 32, BN = WN * 32, ACH = BM / 32, BCH = BN / 32;
  u16* sA = smem;
  u16* sB = smem + 2 * BM * 64;
  int tid_ = ltid();
  const int tid = tid_, lane = tid & 63, wid = tid >> 6, wr = wid >> 1, wc = wid & 1;
  const int l15 = lane & 15, l4 = lane >> 4;
  u32x4 ra0[ACH], rb0[BCH], ra1[ACH], rb1[BCH];
  const int nk = K >> 6;
  const u16* Ap = A + (size_t)(tid >> 3) * lda + (tid & 7) * 8;
  const u16* Bp = Bt + (size_t)(tid >> 3) * ldb + (tid & 7) * 8;
#define GLOAD(ra_, rb_, kt_) do { const int ko_ = (kt_) * 64; \
    _Pragma("unroll") for (int i = 0; i < ACH; i++) ra_[i] = *(const u32x4*)(Ap + (size_t)(32 * i) * lda + ko_); \
    _Pragma("unroll") for (int i = 0; i < BCH; i++) rb_[i] = *(const u32x4*)(Bp + (size_t)(32 * i) * ldb + ko_); } while (0)
#define SSTORE(ra_, rb_, buf_) do { \
    _Pragma("unroll") for (int i = 0; i < ACH; i++) { \
      int idx = tid + 256 * i; u32x4 v = ra_[i]; \
      if (ATR == 1) { float f0, f1; \
        f0 = sigmoidf_(__uint_as_float(v.x << 16)); f1 = sigmoidf_(__uint_as_float(v.x & 0xffff0000u)); v.x = (unsigned)f2bf(f0) | ((unsigned)f2bf(f1) << 16); \
        f0 = sigmoidf_(__uint_as_float(v.y << 16)); f1 = sigmoidf_(__uint_as_float(v.y & 0xffff0000u)); v.y = (unsigned)f2bf(f0) | ((unsigned)f2bf(f1) << 16); \
        f0 = sigmoidf_(__uint_as_float(v.z << 16)); f1 = sigmoidf_(__uint_as_float(v.z & 0xffff0000u)); v.z = (unsigned)f2bf(f0) | ((unsigned)f2bf(f1) << 16); \
        f0 = sigmoidf_(__uint_as_float(v.w << 16)); f1 = sigmoidf_(__uint_as_float(v.w & 0xffff0000u)); v.w = (unsigned)f2bf(f0) | ((unsigned)f2bf(f1) << 16); } \
      *(u32x4*)(sA + (buf_) * BM * 64 + swz(idx >> 3, idx & 7)) = v; } \
    _Pragma("unroll") for (int i = 0; i < BCH; i++) { int idx = tid + 256 * i; *(u32x4*)(sB + (buf_) * BN * 64 + swz(idx >> 3, idx & 7)) = rb_[i]; } \
  } while (0)
#define COMPUTE(buf_) do { \
    const u16* a_ = sA + (buf_) * BM * 64; const u16* b_ = sB + (buf_) * BN * 64; \
    _Pragma("unroll") for (int ks = 0; ks < 2; ks++) { \
      bf16x8 af[WM], bfr[WN]; \
      _Pragma("unroll") for (int mi = 0; mi < WM; mi++) af[mi] = *(const bf16x8*)(a_ + swz(wr * WM * 16 + mi * 16 + l15, ks * 4 + l4)); \
      _Pragma("unroll") for (int ni = 0; ni < WN; ni++) bfr[ni] = *(const bf16x8*)(b_ + swz(wc * WN * 16 + ni * 16 + l15, ks * 4 + l4)); \
      _Pragma("unroll") for (int mi = 0; mi < WM; mi++) \
        _Pragma("unroll") for (int ni = 0; ni < WN; ni++) \
          acc[mi][ni] = __builtin_amdgcn_mfma_f32_16x16x32_bf16(af[mi], bfr[ni], acc[mi][ni], 0, 0, 0); } } while (0)
  GLOAD(ra0, rb0, 0);
  __syncthreads();
  SSTORE(ra0, rb0, 0);
  GLOAD(ra0, rb0, 1);
  if (nk > 2) GLOAD(ra1, rb1, 2);
  __syncthreads();
  for (int kt = 0; kt < nk; kt += 2) {
    COMPUTE(0);
    SSTORE(ra0, rb0, 1);
    if (kt + 3 < nk) GLOAD(ra0, rb0, kt + 3);
    __syncthreads();
    COMPUTE(1);
    if (kt + 2 < nk) SSTORE(ra1, rb1, 0);
    if (kt + 4 < nk) GLOAD(ra1, rb1, kt + 4);
    __syncthreads();
  }
#undef GLOAD
#undef SSTORE
#undef COMPUTE
}

template <int WM, int WN>
__device__ __forceinline__ void store_tile_bf16(f32x4 (&acc)[WM][WN], u16* smem, u16* C, size_t ldc) {
  constexpr int BM = WM * 32, BN = WN * 32, LD = BN + 8, CPR = BN / 8;
  int tid_ = ltid(); asm volatile("" : "+v"(tid_));
  const int tid = tid_, lane = tid & 63, wid = tid >> 6, wr = wid >> 1, wc = wid & 1;
  const int l15 = lane & 15, l4 = lane >> 4;
#pragma unroll
  for (int mi = 0; mi < WM; mi++)
#pragma unroll
    for (int ni = 0; ni < WN; ni++)
#pragma unroll
      for (int j = 0; j < 4; j++)
        smem[(wr * WM * 16 + mi * 16 + l4 * 4 + j) * LD + wc * WN * 16 + ni * 16 + l15] = f2bf(acc[mi][ni][j]);
  __syncthreads();
  for (int idx = tid; idx < BM * CPR; idx += 256) {
    int r = idx / CPR, c = idx % CPR;
    *(uint4*)(C + (size_t)r * ldc + c * 8) = *(const uint4*)(smem + r * LD + c * 8);
  }
}

template <int WM, int WN>
__device__ __forceinline__ void zero_acc(f32x4 (&acc)[WM][WN]) {
#pragma unroll
  for (int mi = 0; mi < WM; mi++)
#pragma unroll
    for (int ni = 0; ni < WN; ni++) acc[mi][ni] = f32x4{0.f, 0.f, 0.f, 0.f};
}

__device__ __forceinline__ void tile_mn(int id, int NT, int& m, int& n) {
  int per = 16 * NT; int mg = id / per; int r = id - mg * per; n = r >> 4; m = mg * 16 + (r & 15);
}

__device__ __forceinline__ void conv_weights(PP p, int l, u16* smem) {
  u16* W = (u16*)(p->ws + WS_W);
  const int tid = ltid();
  const int NTILES = 2592 + 512 + 256 + 1408 + 704 + 16 + 16 + 16;
  for (int tile = blockIdx.x; tile < NTILES; tile += gridDim.x) {
    const float* src; u16* dst; int K, N, ldsrc, tk, tn; int special = 0;
    int t = tile;
    if (t < 2592) { src = p->in[I_WIN] + (size_t)l * 1024 * 10272; ldsrc = 10272; K = 1024; N = WIN_ROWS; dst = W + W_WIN / 2; tk = t & 15; tn = t >> 4; special = 1; }
    else if ((t -= 2592) < 512) { int b = t >> 7; t &= 127; src = p->in[I_WBR] + ((size_t)l * 4 + b) * 512 * 1024; ldsrc = 1024; K = 512; N = 1024; dst = W + W_WBR / 2 + (size_t)b * 1024 * 512; tk = t & 7; tn = t >> 3; }
    else if ((t -= 512) < 256) { src = p->in[I_WOUT] + (size_t)l * 1024 * 1024; ldsrc = 1024; K = 1024; N = 1024; dst = W + W_WOUT / 2; tk = t & 15; tn = t >> 4; }
    else if ((t -= 256) < 1408) { src = p->in[I_FUP] + (size_t)l * 1024 * 5632; ldsrc = 5632; K = 1024; N = 5632; dst = W + W_WUP / 2; tk = t & 15; tn = t >> 4; }
    else if ((t -= 1408) < 704) { src = p->in[I_FDN] + (size_t)l * 2816 * 1024; ldsrc = 1024; K = 2816; N = 1024; dst = W + W_WDN / 2; tk = t % 44; tn = t / 44; }
    else if ((t -= 704) < 16) { src = p->in[I_RGUP] + (size_t)l * 128 * 512; ldsrc = 512; K = 128; N = 512; dst = W + W_WGU / 2; tk = t & 1; tn = t >> 1; }
    else if ((t -= 16) < 16) { int d = t >> 3; t &= 7; src = p->in[I_RWUP] + ((size_t)l * 2 + d) * 64 * 512; ldsrc = 512; K = 64; N = 512; dst = W + W_WWU / 2 + (size_t)d * 512 * 64; tk = 0; tn = t; }
    else { t -= 16; int d = t >> 3; t &= 7; src = p->in[I_RAUP] + ((size_t)l * 2 + d) * 64 * 512; ldsrc = 512; K = 64; N = 512; dst = W + W_WAU / 2 + (size_t)d * 512 * 64; tk = 0; tn = t; }
    __syncthreads();
    {
      int n = tn * 64 + (tid & 63);
      int on = n;
      if (special) {
        if (n < 2816) on = n; else if (n < 6144) on = n + 16; else if (n < 6160) on = 2816 + (n - 6144);
        else if (n < 6176) on = n; else if (n < 6272) on = -1; else on = 6176 + (n - 6272);
      }
#pragma unroll 4
      for (int i = 0; i < 16; i++) {
        int k = (tid >> 6) + i * 4;
        float v = (on >= 0) ? src[(size_t)(tk * 64 + k) * ldsrc + on] : 0.f;
        smem[(tid & 63) * 66 + k] = f2bf(v);
      }
    }
    __syncthreads();
    {
#pragma unroll 4
      for (int i = 0; i < 16; i++) {
        int n = (tid >> 6) + i * 4; int k = tid & 63;
        dst[(size_t)(tn * 64 + n) * K + tk * 64 + k] = smem[n * 66 + k];
      }
    }
  }
}

__device__ __forceinline__ void phase_prep(PP p, char* smem_raw) {
  const int tid = ltid();
  float* rc = (float*)(p->ws + WS_ROPE); float* rs = rc + 4096 * 32;
  for (int idx = blockIdx.x * 256 + tid; idx < 4096 * 32; idx += gridDim.x * 256) {
    int t = idx >> 5, j = idx & 31; int i = j & 15;
    float inv = exp2f(-(float)i * (13.287712379549449f / 16.f));
    float ang = (float)((j < 16) ? (t >> 6) : (t & 63)) * inv;
    float rev = ang * 0.15915494309189535f; rev -= floorf(rev);
    rc[idx] = __builtin_amdgcn_cosf(rev); rs[idx] = __builtin_amdgcn_sinf(rev);
  }
  float* sc = (float*)smem_raw;
  float* red = sc + 9 * 1024;
  float* mod = (float*)(p->ws + WS_MOD);
  for (int item = blockIdx.x; item < 192; item += gridDim.x) {
    int l = item / 96, cb = item % 96;
    __syncthreads();
    for (int i = tid; i < 9 * 1024; i += 256) {
      int v = i >> 10, k = i & 1023;
      float x = (v == 0) ? p->in[I_CCTX][k] : p->in[I_C][(v - 1) * 1024 + k];
      sc[i] = siluf_(x);
    }
    __syncthreads();
    int cl = tid & 63, kq = tid >> 6; int n = cb * 64 + cl;
    float acc[9];
#pragma unroll
    for (int v = 0; v < 9; v++) acc[v] = 0.f;
    const float* w = p->in[I_ADAW] + (size_t)l * 1024 * 6144 + n;
    for (int k = kq * 256; k < kq * 256 + 256; k++) {
      float wv = w[(size_t)k * 6144];
#pragma unroll
      for (int v = 0; v < 9; v++) acc[v] += sc[v * 1024 + k] * wv;
    }
#pragma unroll
    for (int v = 0; v < 9; v++) red[(kq * 9 + v) * 64 + cl] = acc[v];
    __syncthreads();
    for (int i = tid; i < 9 * 64; i += 256) {
      int v = i >> 6, c = i & 63;
      float s = red[(0 * 9 + v) * 64 + c] + red[(1 * 9 + v) * 64 + c] + red[(2 * 9 + v) * 64 + c] + red[(3 * 9 + v) * 64 + c];
      mod[((size_t)l * 9 + v) * 6144 + cb * 64 + c] = s + p->in[I_ADAB][(size_t)l * 6144 + cb * 64 + c];
    }
  }
  __syncthreads();
  conv_weights(p, 0, (u16*)smem_raw);
}

__device__ __forceinline__ void phase_norm(PP p, int l, int g, int which) {
  const int lane = ltid() & 63, wid = ltid() >> 6;
  const float* mod = (const float*)(p->ws + WS_MOD) + (size_t)l * 9 * 6144;
  const float* nw = p->in[which ? I_N2 : I_N1] + (size_t)l * 1024;
  u16* H = (u16*)(p->ws + WS_H);
  for (int rg = blockIdx.x * 4 + wid; rg < GROWS / 4; rg += gridDim.x * 4) {
    const int r0 = rg * 4;
    int grow = g * GROWS + r0; int t, T, mi; row_info(grow, t, T, mi);
    const float* x;
    if (l == 0 && which == 0) x = (grow < 8192) ? p->in[I_XP] + (size_t)grow * 1024 : p->in[I_XS] + (size_t)(grow - 8192) * 1024;
    else x = p->out + (size_t)grow * 1024;
    float4 v[4][4]; float ss[4];
#pragma unroll
    for (int k = 0; k < 4; k++)
#pragma unroll
      for (int i = 0; i < 4; i++) v[k][i] = *(const float4*)(x + k * 1024 + i * 256 + lane * 4);
#pragma unroll
    for (int k = 0; k < 4; k++) {
      float a_ = 0.f;
#pragma unroll
      for (int i = 0; i < 4; i++) a_ += v[k][i].x * v[k][i].x + v[k][i].y * v[k][i].y + v[k][i].z * v[k][i].z + v[k][i].w * v[k][i].w;
      ss[k] = a_;
    }
#pragma unroll
    for (int o = 32; o > 0; o >>= 1) {
#pragma unroll
      for (int k = 0; k < 4; k++) ss[k] += __shfl_xor(ss[k], o);
    }
    const float* sh = mod + (size_t)mi * 6144 + (which ? 3 : 0) * 1024;
    const float* sca = sh + 1024;
    float rinv[4];
#pragma unroll
    for (int k = 0; k < 4; k++) rinv[k] = rsqrtf(ss[k] * (1.f / 1024.f) + 1e-6f);
#pragma unroll
    for (int i = 0; i < 4; i++) {
      int c = i * 256 + lane * 4;
      float4 w4 = *(const float4*)(nw + c), s4 = *(const float4*)(sca + c), h4 = *(const float4*)(sh + c);
      float m0 = w4.x * (1.f + s4.x), m1 = w4.y * (1.f + s4.y), m2 = w4.z * (1.f + s4.z), m3 = w4.w * (1.f + s4.w);
#pragma unroll
      for (int k = 0; k < 4; k++) {
        float o0 = v[k][i].x * rinv[k] * m0 + h4.x;
        float o1 = v[k][i].y * rinv[k] * m1 + h4.y;
        float o2 = v[k][i].z * rinv[k] * m2 + h4.z;
        float o3 = v[k][i].w * rinv[k] * m3 + h4.w;
        uint2 o; o.x = (unsigned)f2bf(o0) | ((unsigned)f2bf(o1) << 16); o.y = (unsigned)f2bf(o2) | ((unsigned)f2bf(o3) << 16);
        *(uint2*)(H + (size_t)(r0 + k) * 1024 + c) = o;
      }
    }
  }
}

__device__ __forceinline__ void phase_gemm1(PP p, int l, int g, u16* smem) {
  const u16* H = (const u16*)(p->ws + WS_H);
  const u16* W = (const u16*)(p->ws + WS_W + W_WIN);
  u16* P = (u16*)(p->ws + WS_P);
  const float* rc = (const float*)(p->ws + WS_ROPE); const float* rs = rc + 4096 * 32;
  const int lane = ltid() & 63, wid = ltid() >> 6, wr = wid >> 1, wc = wid & 1, l15 = lane & 15, l4 = lane >> 4;
  const int NT = PW / 128;
  for (int id = blockIdx.x; id < 160 * NT; id += gridDim.x) {
    int m, n; tile_mn(id, NT, m, n);
    f32x4 acc[4][4]; zero_acc<4, 4>(acc);
    gemm_main<4, 4, 0>(acc, H + (size_t)m * 128 * 1024, 1024, W + (size_t)n * 128 * 1024, 1024, 1024, smem);
    const int col0 = n * 128 + wc * 64;
    if (col0 < 512) {
      const bool isq = col0 < 256;
#pragma unroll
      for (int mi = 0; mi < 4; mi++)
#pragma unroll
        for (int j = 0; j < 4; j++) {
          int grow = g * GROWS + m * 128 + wr * 64 + mi * 16 + l4 * 4 + j;
          if (grow >= 8192) {
            int t = (grow - 8192) & 4095;
#pragma unroll
            for (int ni = 0; ni < 2; ni++) {
              float c = rc[t * 32 + ni * 16 + l15], s = rs[t * 32 + ni * 16 + l15];
              float x1 = acc[mi][ni][j], x2 = acc[mi][ni + 2][j];
              acc[mi][ni][j] = x1 * c - x2 * s; acc[mi][ni + 2][j] = x1 * s + x2 * c;
            }
          }
          if (isq) {
#pragma unroll
            for (int ni = 0; ni < 4; ni++) acc[mi][ni][j] *= 0.125f;
          }
        }
    } else if (col0 >= C_MQ && col0 < C_MK) {
#pragma unroll
      for (int mi = 0; mi < 4; mi++)
#pragma unroll
        for (int ni = 0; ni < 4; ni++) acc[mi][ni] *= 0.125f;
    }
    store_tile_bf16<4, 4>(acc, smem, P + (size_t)m * 128 * PW + n * 128, PW);
  }
}

__device__ __forceinline__ void conv8_silu(const u16* prow, int t, int T, int col, const float* cw, const float* cb, int cidx, int cstride, float* out) {
  float xm[8], x0[8], xp[8];
  uint4 z = make_uint4(0, 0, 0, 0);
  uint4 vm = *(const uint4*)(prow - ((t > 0) ? PW : 0) + col);
  uint4 v0 = *(const uint4*)(prow + col);
  uint4 vp = *(const uint4*)(prow + ((t < T - 1) ? PW : 0) + col);
  if (!(t > 0)) vm = z;
  if (!(t < T - 1)) vp = z;
  unpack8(vm, xm); unpack8(v0, x0); unpack8(vp, xp);
#pragma unroll
  for (int e = 0; e < 8; e++) {
    float y = xm[e] * cw[cidx + e] + x0[e] * cw[cstride + cidx + e] + xp[e] * cw[2 * cstride + cidx + e];
    if (cb) { y += cb[cidx + e]; y = siluf_(y); }
    out[e] = y;
  }
}

__device__ __forceinline__ void conv8_rows(const uint4& vm, const uint4& v0, const uint4& vp, const float* cw, const float* cb, int cidx, int cstride, float* out) {
  float xm[8], x0[8], xp[8];
  unpack8(vm, xm); unpack8(v0, x0); unpack8(vp, xp);
#pragma unroll
  for (int e = 0; e < 8; e++) {
    float y = xm[e] * cw[cidx + e] + x0[e] * cw[cstride + cidx + e] + xp[e] * cw[2 * cstride + cidx + e];
    if (cb) { y += cb[cidx + e]; y = siluf_(y); }
    out[e] = y;
  }
}

template <int MIX>
__device__ __forceinline__ void chunk_scan(PP p, int l, int g, int seq, int head, int dir, char* smem_raw) {
  constexpr int NT = (MIX == 0) ? 8 : ((MIX == 1) ? 4 : 9);
  constexpr int VD = (MIX == 1) ? 64 : 128;
  u16* sQ = (u16*)smem_raw; u16* sK = sQ + 4096; u16* sKT = sK + 4096; u16* sATT = sKT + 4096;
  u16* sVT = sATT + 4096; u16* sST = sVT + 144 * 64;
  float* sF = (float*)(sST + 144 * 64);
  float* sRow = sF; float* sCol = sF + 64; float* sCoef = sF + 128; float* sTail = sF + 192; float* sFloor = sF + 256; float* sDt = sF + 320; float* sMisc = sF + 384; float* sCw = sF + 400;
  int tid_ = ltid(); asm volatile("" : "+v"(tid_));
  const int tid = tid_, lane = tid & 63, w = tid >> 6, l15 = lane & 15, l4 = lane >> 4;
  const bool lat = seq >= 32; const int b = seq - 32;
  const int T = lat ? 4096 : 256;
  const int lbase = (lat ? 8192 + b * 4096 : seq * 256) - g * GROWS;
  const u16* Pb = (const u16*)(p->ws + WS_P) + (size_t)lbase * PW;
  u16* Yd = (u16*)(p->ws + WS_Y) + ((size_t)dir * GROWS + lbase) * 2048 + ((MIX == 0) ? 0 : (MIX == 1 ? 512 : 1536)) + head * VD;
  const int HH = (MIX == 1) ? 8 : 4;
  const int pidx = (l * 2 + dir) * HH + head;
  float c1 = 0.f, c2 = 0.f;
  if (MIX == 0) c1 = -__expf(p->in[I_RLR][pidx]);
  if (MIX == 1) { c1 = -__expf(p->in[I_SAL][pidx]); c2 = p->in[I_SDTB][pidx]; }
  if (MIX == 2) { c1 = p->in[I_MIB][pidx]; c2 = p->in[I_MFB][pidx]; }
  const int qcol = (MIX == 0) ? C_RQ + head * 64 : ((MIX == 1) ? C_SC + (head >> 2) * 64 : C_MQ + head * 64);
  const int kcol = (MIX == 0) ? C_RK + head * 64 : ((MIX == 1) ? C_SB + (head >> 2) * 64 : C_MK + head * 64);
  const int vcol = (MIX == 0) ? C_RV + head * 128 : ((MIX == 1) ? C_SX + head * 64 : C_MV + head * 128);
  const float* scw = p->in[I_SCW] + (size_t)l * 3 * 768; const float* scb = p->in[I_SCB] + (size_t)l * 768;

  __syncthreads();
  if (MIX == 1) {
    for (int i = tid; i < 768; i += 256) {
      int grp = i / 192, c = i % 192, sub = c >> 6, cc = c & 63;
      int cb0 = (sub == 0) ? 640 + (head >> 2) * 64 : ((sub == 1) ? 512 + (head >> 2) * 64 : head * 64);
      sCw[i] = (grp < 3) ? scw[grp * 768 + cb0 + cc] : scb[cb0 + cc];
    }
  }
  f32x4 accS[NT];
  float mstate = 0.f;
#pragma unroll
  for (int ni = 0; ni < NT; ni++) accS[ni] = f32x4{0.f, 0.f, 0.f, 0.f};
  if (lat) {
    const size_t sb = (size_t)((b * 2 + l) * 2 + dir) * HH + head;
    const float* s0 = (MIX == 0) ? p->in[I_SRET] + sb * 64 * 128 : ((MIX == 1) ? p->in[I_SSSD] + sb * 64 * 64 : p->in[I_SC] + sb * 64 * 128);
#pragma unroll
    for (int ni = 0; ni < VD / 16; ni++)
#pragma unroll
      for (int j = 0; j < 4; j++) accS[ni][j] = s0[(size_t)(16 * w + l4 * 4 + j) * VD + ni * 16 + l15];
    if (MIX == 2) {
#pragma unroll
      for (int j = 0; j < 4; j++) accS[NT - 1][j] = (l15 == 0) ? p->in[I_SN][sb * 64 + 16 * w + l4 * 4 + j] : 0.f;
      mstate = p->in[I_SM][sb];
    }
  }
#pragma unroll
  for (int ni = 0; ni < NT; ni++) {
    uint2 o; o.x = (unsigned)f2bf(accS[ni][0]) | ((unsigned)f2bf(accS[ni][1]) << 16); o.y = (unsigned)f2bf(accS[ni][2]) | ((unsigned)f2bf(accS[ni][3]) << 16);
    *(uint2*)(sST + sidx(ni * 16 + l15, 16 * w + l4 * 4)) = o;
  }
  if (MIX == 2) { for (int i = tid; i < 16 * 64; i += 256) { int r = 128 + (i >> 6), c = i & 63; sVT[sidx(r, c)] = (r == 128) ? (u16)0x3F80 : (u16)0; } }

  const int nch = T >> 6;
  constexpr int NR = (MIX == 1) ? 3 : 1;
  constexpr int NVT = VD / 32;
  const int ptok = tid >> 2, ppart = tid & 3;
  u32x4 gq[2 * NR], gk[2 * NR], gv[NVT * NR];
  unsigned gs0 = 0, gs1 = 0;
  const u32x4 zz = {0u, 0u, 0u, 0u};
#define CS_LD3(dst_, i_, ptr_, t_) do { if (NR == 1) dst_[i_] = *(const u32x4*)(ptr_); else { \
      dst_[(i_) * NR] = *(const u32x4*)((ptr_) - (((t_) > 0) ? PW : 0)); dst_[(i_) * NR + 1] = *(const u32x4*)(ptr_); \
      dst_[(i_) * NR + NR - 1] = *(const u32x4*)((ptr_) + (((t_) < T - 1) ? PW : 0)); } } while (0)
#define CS_GLOAD(ci_) do { \
    { int pos_ = (ci_) * 64 + ptok; int t_ = dir ? (T - 1 - pos_) : pos_; const u16* pr_ = Pb + (size_t)t_ * PW; \
      _Pragma("unroll") for (int c_ = 0; c_ < 2; c_++) { CS_LD3(gq, c_, pr_ + qcol + (ppart * 2 + c_) * 8, t_); CS_LD3(gk, c_, pr_ + kcol + (ppart * 2 + c_) * 8, t_); } \
      _Pragma("unroll") for (int c_ = 0; c_ < NVT; c_++) { CS_LD3(gv, c_, pr_ + vcol + (ppart * NVT + c_) * 8, t_); } } \
    if (MIX != 0 && w == 0) { int pos_ = (ci_) * 64 + lane; int t_ = dir ? (T - 1 - pos_) : pos_; const u16* pr_ = Pb + (size_t)t_ * PW; \
      if (MIX == 1) gs0 = pr_[C_DT + dir * 8 + head]; else { gs0 = pr_[C_IF + dir * 8 + head]; gs1 = pr_[C_IF + dir * 8 + 4 + head]; } } \
  } while (0)
  CS_GLOAD(0);
  for (int ci = 0; ci < nch; ci++) {
    if (w == 0) {
      float lb, ib = 0.f;
      if (MIX == 0) lb = c1;
      else if (MIX == 1) { float dtv = softplusf_(bf2f((u16)gs0) + c2); sDt[lane] = dtv; lb = dtv * c1; }
      else { ib = bf2f((u16)gs0) + c1; lb = -softplusf_(-(bf2f((u16)gs1) + c2)); }
      float cs = lb;
#pragma unroll
      for (int o = 1; o < 64; o <<= 1) { float v = __shfl_up(cs, o); if (lane >= o) cs += v; }
      float cs63 = __shfl(cs, 63);
      if (MIX != 2) {
        sRow[lane] = cs; sCol[lane] = -cs; sCoef[lane] = fexp_(cs); sTail[lane] = fexp_(cs63 - cs);
        if (lane == 0) sMisc[0] = fexp_(cs63);
      } else {
        float gg = ib - cs; float pm = gg;
#pragma unroll
        for (int o = 1; o < 64; o <<= 1) { float v = __shfl_up(pm, o); if (lane >= o) pm = fmaxf(pm, v); }
        float M = fmaxf(mstate, pm); float M63 = __shfl(M, 63);
        sRow[lane] = -M; sCol[lane] = gg; sCoef[lane] = fexp_(mstate - M); sTail[lane] = fexp_(gg - M63); sFloor[lane] = fexp_(-cs - M);
        if (lane == 0) sMisc[0] = fexp_(mstate - M63);
        mstate = cs63 + M63;
      }
    }
    __syncthreads();
    {
      const float tl = sTail[ptok];
#pragma unroll
      for (int c = 0; c < 4; c++) {
        const int which = c >> 1, cc = c & 1, ch = ppart * 2 + cc;
        float f[8];
        u32x4 vq;
        if (MIX == 1) {
          const float* cwp = sCw + which * 64 + ch * 8;
          float xm[8], x0[8], xp[8];
          u32x4 r0 = which ? gk[cc * NR] : gq[cc * NR], r1 = which ? gk[cc * NR + 1] : gq[cc * NR + 1], r2 = which ? gk[cc * NR + NR - 1] : gq[cc * NR + NR - 1];
          { const int pos2 = ci * 64 + ptok; const int t2 = dir ? (T - 1 - pos2) : pos2; if (!(t2 > 0)) r0 = zz; if (!(t2 < T - 1)) r2 = zz; }
          uint4 t4; t4.x = r0.x; t4.y = r0.y; t4.z = r0.z; t4.w = r0.w; unpack8(t4, xm);
          t4.x = r1.x; t4.y = r1.y; t4.z = r1.z; t4.w = r1.w; unpack8(t4, x0);
          t4.x = r2.x; t4.y = r2.y; t4.z = r2.z; t4.w = r2.w; unpack8(t4, xp);
#pragma unroll
          for (int e = 0; e < 8; e++) f[e] = siluf_(xm[e] * cwp[e] + x0[e] * cwp[192 + e] + xp[e] * cwp[384 + e] + cwp[576 + e]);
          uint4 pk = pack8(f); vq.x = pk.x; vq.y = pk.y; vq.z = pk.z; vq.w = pk.w;
        } else {
          vq = which ? gk[cc] : gq[cc];
          uint4 t4; t4.x = vq.x; t4.y = vq.y; t4.z = vq.z; t4.w = vq.w; unpack8(t4, f);
        }
        if (which == 0) { *(u32x4*)(sQ + swz(ptok, ch)) = vq; }
        else {
          *(u32x4*)(sK + swz(ptok, ch)) = vq;
#pragma unroll
          for (int e = 0; e < 8; e++) sKT[sidx(ch * 8 + e, ptok)] = f2bf(f[e] * tl);
        }
        __builtin_amdgcn_sched_barrier(0);
      }
      float dtv = (MIX == 1) ? sDt[ptok] : 1.f;
#pragma unroll
      for (int c = 0; c < NVT; c++) {
        const int ch = ppart * NVT + c;
        float f[8];
        if (MIX == 1) {
          const float* cwp = sCw + 128 + ch * 8;
          float xm[8], x0[8], xp[8];
          u32x4 g0 = gv[c * NR], g2 = gv[c * NR + NR - 1];
          { const int pos2 = ci * 64 + ptok; const int t2 = dir ? (T - 1 - pos2) : pos2; if (!(t2 > 0)) g0 = zz; if (!(t2 < T - 1)) g2 = zz; }
          uint4 t4; t4.x = g0.x; t4.y = g0.y; t4.z = g0.z; t4.w = g0.w; unpack8(t4, xm);
          t4.x = gv[c * NR + 1].x; t4.y = gv[c * NR + 1].y; t4.z = gv[c * NR + 1].z; t4.w = gv[c * NR + 1].w; unpack8(t4, x0);
          t4.x = g2.x; t4.y = g2.y; t4.z = g2.z; t4.w = g2.w; unpack8(t4, xp);
#pragma unroll
          for (int e = 0; e < 8; e++) f[e] = dtv * siluf_(xm[e] * cwp[e] + x0[e] * cwp[192 + e] + xp[e] * cwp[384 + e] + cwp[576 + e]);
        } else {
          uint4 t4; t4.x = gv[c].x; t4.y = gv[c].y; t4.z = gv[c].z; t4.w = gv[c].w; unpack8(t4, f);
        }
#pragma unroll
        for (int e = 0; e < 8; e++) sVT[sidx(ch * 8 + e, ptok)] = f2bf(f[e]);
        __builtin_amdgcn_sched_barrier(0);
      }
    }
    __syncthreads();
    {
      f32x4 at[4];
#pragma unroll
      for (int ni = 0; ni < 4; ni++) at[ni] = f32x4{0.f, 0.f, 0.f, 0.f};
#pragma unroll
      for (int ks = 0; ks < 2; ks++) {
        bf16x8 a = *(const bf16x8*)(sQ + swz(16 * w + l15, ks * 4 + l4));
#pragma unroll
        for (int ni = 0; ni < 4; ni++) {
          bf16x8 bb = *(const bf16x8*)(sK + swz(16 * ni + l15, ks * 4 + l4));
          at[ni] = __builtin_amdgcn_mfma_f32_16x16x32_bf16(a, bb, at[ni], 0, 0, 0);
        }
      }
      float rw[4];
#pragma unroll
      for (int j = 0; j < 4; j++) rw[j] = sRow[16 * w + l4 * 4 + j];
#pragma unroll
      for (int ni = 0; ni < 4; ni++) {
        float cv = sCol[16 * ni + l15];
#pragma unroll
        for (int j = 0; j < 4; j++) {
          int r = 16 * w + l4 * 4 + j, c = 16 * ni + l15;
          float val = (c <= r) ? at[ni][j] * fexp_(rw[j] + cv) : 0.f;
          sATT[sidx(r, c)] = f2bf(val);
        }
      }
    }
    __syncthreads();
    {
      float cf[4], dv[4] = {1.f, 1.f, 1.f, 1.f};
#pragma unroll
      for (int j = 0; j < 4; j++) cf[j] = sCoef[16 * w + l4 * 4 + j];
      if (MIX == 2) {
        f32x4 ad = {0.f, 0.f, 0.f, 0.f};
#pragma unroll
        for (int ks = 0; ks < 2; ks++) {
          bf16x8 a = *(const bf16x8*)(sQ + swz(16 * w + l15, ks * 4 + l4));
          bf16x8 bb = *(const bf16x8*)(sST + swz(16 * 8 + l15, ks * 4 + l4));
          ad = __builtin_amdgcn_mfma_f32_16x16x32_bf16(a, bb, ad, 0, 0, 0);
        }
#pragma unroll
        for (int j = 0; j < 4; j++) ad[j] *= cf[j];
#pragma unroll
        for (int ks = 0; ks < 2; ks++) {
          bf16x8 a = *(const bf16x8*)(sATT + swz(16 * w + l15, ks * 4 + l4));
          bf16x8 bb = *(const bf16x8*)(sVT + swz(16 * 8 + l15, ks * 4 + l4));
          ad = __builtin_amdgcn_mfma_f32_16x16x32_bf16(a, bb, ad, 0, 0, 0);
        }
#pragma unroll
        for (int j = 0; j < 4; j++) {
          float den = __shfl(ad[j], lane & 48);
          dv[j] = __builtin_amdgcn_rcpf(fmaxf(fabsf(den), sFloor[16 * w + l4 * 4 + j]));
        }
      }
#pragma unroll 1
      for (int grp = 0; grp < VD / 64; grp++) {
        f32x4 ay[4];
#pragma unroll
        for (int ni = 0; ni < 4; ni++) ay[ni] = f32x4{0.f, 0.f, 0.f, 0.f};
#pragma unroll
        for (int ks = 0; ks < 2; ks++) {
          bf16x8 a = *(const bf16x8*)(sQ + swz(16 * w + l15, ks * 4 + l4));
#pragma unroll
          for (int ni = 0; ni < 4; ni++) {
            bf16x8 bb = *(const bf16x8*)(sST + swz(16 * (grp * 4 + ni) + l15, ks * 4 + l4));
            ay[ni] = __builtin_amdgcn_mfma_f32_16x16x32_bf16(a, bb, ay[ni], 0, 0, 0);
          }
        }
#pragma unroll
        for (int ni = 0; ni < 4; ni++)
#pragma unroll
          for (int j = 0; j < 4; j++) ay[ni][j] *= cf[j];
#pragma unroll
        for (int ks = 0; ks < 2; ks++) {
          bf16x8 a = *(const bf16x8*)(sATT + swz(16 * w + l15, ks * 4 + l4));
#pragma unroll
          for (int ni = 0; ni < 4; ni++) {
            bf16x8 bb = *(const bf16x8*)(sVT + swz(16 * (grp * 4 + ni) + l15, ks * 4 + l4));
            ay[ni] = __builtin_amdgcn_mfma_f32_16x16x32_bf16(a, bb, ay[ni], 0, 0, 0);
          }
        }
#pragma unroll
        for (int j = 0; j < 4; j++) {
          int pos = ci * 64 + 16 * w + l4 * 4 + j; int t = dir ? (T - 1 - pos) : pos;
          u16* yrow = Yd + (size_t)t * 2048 + grp * 64;
#pragma unroll
          for (int ni = 0; ni < 4; ni++) yrow[ni * 16 + l15] = f2bf(ay[ni][j] * dv[j]);
        }
      }
    }
    if (ci + 1 < nch) CS_GLOAD(ci + 1);
    __syncthreads();
    {
      float sc = sMisc[0];
#pragma unroll
      for (int ni = 0; ni < NT; ni++) accS[ni] *= sc;
#pragma unroll 1
      for (int ks = 0; ks < 2; ks++) {
        bf16x8 a = *(const bf16x8*)(sKT + swz(16 * w + l15, ks * 4 + l4));
#pragma unroll
        for (int ni = 0; ni < NT; ni++) {
          bf16x8 bb = *(const bf16x8*)(sVT + swz(16 * ni + l15, ks * 4 + l4));
          accS[ni] = __builtin_amdgcn_mfma_f32_16x16x32_bf16(a, bb, accS[ni], 0, 0, 0);
        }
      }
#pragma unroll
      for (int ni = 0; ni < NT; ni++) {
        uint2 o; o.x = (unsigned)f2bf(accS[ni][0]) | ((unsigned)f2bf(accS[ni][1]) << 16); o.y = (unsigned)f2bf(accS[ni][2]) | ((unsigned)f2bf(accS[ni][3]) << 16);
        *(uint2*)(sST + sidx(ni * 16 + l15, 16 * w + l4 * 4)) = o;
      }
    }
    __syncthreads();
  }
  if (!lat && !DBGSTOP) {
    const size_t sb = (size_t)((seq * 2 + l) * 2 + dir) * HH + head;
    float* o = p->out + ((MIX == 0) ? O_RET + sb * 64 * 128 : ((MIX == 1) ? O_SSD + sb * 64 * 64 : O_C + sb * 64 * 128));
#pragma unroll
    for (int ni = 0; ni < VD / 16; ni++)
#pragma unroll
      for (int j = 0; j < 4; j++) o[(size_t)(16 * w + l4 * 4 + j) * VD + ni * 16 + l15] = accS[ni][j];
    if (MIX == 2) {
      if (l15 == 0) {
#pragma unroll
        for (int j = 0; j < 4; j++) p->out[O_N + sb * 64 + 16 * w + l4 * 4 + j] = accS[NT - 1][j];
      }
      if (tid == 0) p->out[O_M + sb] = mstate;
    }
  }
}

typedef float f2v __attribute__((ext_vector_type(2)));
__device__ __forceinline__ float dpp_f(float x, const int ctrl_sel) {
  int xi = __float_as_int(x); int r;
  if (ctrl_sel == 0) r = __builtin_amdgcn_update_dpp(0, xi, 0xB1, 0xF, 0xF, true);
  else if (ctrl_sel == 1) r = __builtin_amdgcn_update_dpp(0, xi, 0x4E, 0xF, 0xF, true);
  else r = __builtin_amdgcn_update_dpp(0, xi, 0x141, 0xF, 0xF, true);
  return __int_as_float(r);
}
__device__ __forceinline__ float red8(float x) { x += dpp_f(x, 0); x += dpp_f(x, 1); x += dpp_f(x, 2); return x; }

struct RwOps { f2v w[4], a[4], b[4], k[4], r[4]; float v; };
#define RW_LOAD(o_, i_) do { const float* bs_ = sW + (i_) * 64 + ks * 8; \
    _Pragma("unroll") for (int q_ = 0; q_ < 4; q_++) { \
      o_.w[q_] = *(const f2v*)(bs_ + 2 * q_); o_.a[q_] = *(const f2v*)(bs_ + 2048 + 2 * q_); o_.b[q_] = *(const f2v*)(bs_ + 4096 + 2 * q_); \
      o_.k[q_] = *(const f2v*)(bs_ + 6144 + 2 * q_); o_.r[q_] = *(const f2v*)(bs_ + 8192 + 2 * q_); } \
    o_.v = sV[(i_) * 64 + vrow]; } while (0)

__device__ __forceinline__ void rwkv_scan(PP p, int l, int g, int seq, int head, int dir, int vhalf, char* smem_raw) {
  float* sW = (float*)smem_raw; float* sA = sW + 2048; float* sB = sA + 2048; float* sKD = sB + 2048; float* sR = sKD + 2048; float* sV = sR + 2048;
  u16* sWL = (u16*)(sV + 2048); u16* sAD = sWL + 2048;
  u16* sY = (u16*)(smem_raw + 77824);
  u16* sUW = sAD + 2048; u16* sUA = sUW + 4096;
  float* sCst = (float*)(sUA + 4096);
  int tid_ = ltid(); asm volatile("" : "+v"(tid_));
  const int tid = tid_, lane = tid & 63, w = tid >> 6, l15 = lane & 15, l4 = lane >> 4;
  const bool lat = seq >= 32; const int b = seq - 32;
  const int T = lat ? 4096 : 256;
  const int lbase = (lat ? 8192 + b * 4096 : seq * 256) - g * GROWS;
  const u16* Pb = (const u16*)(p->ws + WS_P) + (size_t)lbase * PW;
  u16* Yd = (u16*)(p->ws + WS_Y) + ((size_t)dir * GROWS + lbase) * 2048 + 1024 + head * 64 + vhalf * 32;
  float* bon = (float*)(p->ws + WS_BON) + ((size_t)dir * GROWS + lbase) * 8 + head;
  const int hc = head * 64;
  const float* w0 = sCst + 576; const float* a0 = sCst + 640; const float* kkp = sCst + 704; const float* kap = sCst + 768; const float* rkp = sCst + 832;
  const int ks = lane & 7, rp = lane >> 3;
  const int vrow = vhalf * 32 + 8 * w + rp;

  __syncthreads();
  {
    const float* rcw = p->in[I_RCW] + (size_t)l * 3 * 1536;
    for (int i = tid; i < 576; i += 256) { int it = i / 192, tap = (i / 64) % 3, c = i & 63; sCst[i] = rcw[tap * 1536 + it * 512 + hc + c]; }
    if (tid < 64) {
      sCst[576 + tid] = p->in[I_RW0][(size_t)(l * 2 + dir) * 512 + hc + tid];
      sCst[640 + tid] = p->in[I_RA0][(size_t)(l * 2 + dir) * 512 + hc + tid];
      sCst[704 + tid] = p->in[I_RKK][(size_t)l * 512 + hc + tid];
      sCst[768 + tid] = p->in[I_RKA][(size_t)l * 512 + hc + tid];
      sCst[832 + tid] = p->in[I_RRK][(size_t)l * 512 + hc + tid];
    }
  }
  {
    const u16* uw = (const u16*)(p->ws + WS_W + W_WWU) + ((size_t)dir * 512 + hc) * 64;
    const u16* ua = (const u16*)(p->ws + WS_W + W_WAU) + ((size_t)dir * 512 + hc) * 64;
    for (int i = tid; i < 512; i += 256) {
      int r = i >> 3, c = i & 7;
      *(uint4*)(sUW + swz(r, c)) = *(const uint4*)(uw + r * 64 + c * 8);
      *(uint4*)(sUA + swz(r, c)) = *(const uint4*)(ua + r * 64 + c * 8);
    }
  }
  f2v S[4];
#pragma unroll
  for (int e = 0; e < 4; e++) S[e] = f2v{0.f, 0.f};
  if (lat) {
    const float* s0 = p->in[I_SRWKV] + ((size_t)((b * 2 + l) * 2 + dir) * 8 + head) * 4096 + (size_t)vrow * 64 + ks * 8;
#pragma unroll
    for (int e = 0; e < 4; e++) S[e] = *(const f2v*)(s0 + 2 * e);
  }
  const int ptok = tid >> 3, pch = tid & 7;
  u32x4 gl[2], gc[9];
  const u32x4 zz = {0u, 0u, 0u, 0u};
#define RW_GLOAD(ci_) do { \
    { int pos_ = (ci_) * 32 + ptok; int t_ = dir ? (T - 1 - pos_) : pos_; const u16* pr_ = Pb + (size_t)t_ * PW; \
      gl[0] = *(const u32x4*)(pr_ + C_WW + pch * 8); gl[1] = *(const u32x4*)(pr_ + C_WA + pch * 8); \
      _Pragma("unroll") for (int it_ = 0; it_ < 3; it_++) { const u16* q_ = pr_ + C_WR + it_ * 512 + hc + pch * 8; \
        gc[it_ * 3 + 0] = *(const u32x4*)(q_ - ((t_ > 0) ? PW : 0)); gc[it_ * 3 + 1] = *(const u32x4*)(q_); \
        gc[it_ * 3 + 2] = *(const u32x4*)(q_ + ((t_ < T - 1) ? PW : 0)); } } } while (0)
  RW_GLOAD(0);
  const int nsub = T >> 5;
  __syncthreads();
  for (int ci = 0; ci < nsub; ci++) {
    {
      float f[8];
      { uint4 v; v.x = gl[0].x; v.y = gl[0].y; v.z = gl[0].z; v.w = gl[0].w; unpack8(v, f);
#pragma unroll
        for (int e = 0; e < 8; e++) f[e] = tanhf_(f[e]);
        *(uint4*)(sWL + swz(ptok, pch)) = pack8(f);
        uint4 v2; v2.x = gl[1].x; v2.y = gl[1].y; v2.z = gl[1].z; v2.w = gl[1].w;
        *(uint4*)(sAD + swz(ptok, pch)) = v2; }
#pragma unroll
      for (int it = 0; it < 3; it++) {
        float xm[8], x0[8], xp[8];
        const int pos1 = ci * 32 + ptok; const int t1 = dir ? (T - 1 - pos1) : pos1;
        const u32x4 gm = (t1 > 0) ? gc[it * 3] : zz, gp = (t1 < T - 1) ? gc[it * 3 + 2] : zz;
        uint4 v; v.x = gm.x; v.y = gm.y; v.z = gm.z; v.w = gm.w; unpack8(v, xm);
        v.x = gc[it * 3 + 1].x; v.y = gc[it * 3 + 1].y; v.z = gc[it * 3 + 1].z; v.w = gc[it * 3 + 1].w; unpack8(v, x0);
        v.x = gp.x; v.y = gp.y; v.z = gp.z; v.w = gp.w; unpack8(v, xp);
        const float* cw = sCst + it * 192 + pch * 8;
#pragma unroll
        for (int e = 0; e < 8; e++) f[e] = xm[e] * cw[e] + x0[e] * cw[64 + e] + xp[e] * cw[128 + e];
        float* dst = (it == 0) ? sR : ((it == 1) ? sKD : sV);
        *(float4*)(dst + ptok * 64 + pch * 8) = make_float4(f[0], f[1], f[2], f[3]);
        *(float4*)(dst + ptok * 64 + pch * 8 + 4) = make_float4(f[4], f[5], f[6], f[7]);
      }
    }
    __syncthreads();
    {
#pragma unroll
      for (int mi = 0; mi < 2; mi++) {
        f32x4 aw = {0.f, 0.f, 0.f, 0.f}, aa = {0.f, 0.f, 0.f, 0.f};
#pragma unroll
        for (int k2 = 0; k2 < 2; k2++) {
          bf16x8 x1 = *(const bf16x8*)(sWL + swz(mi * 16 + l15, k2 * 4 + l4));
          bf16x8 y1 = *(const bf16x8*)(sUW + swz(16 * w + l15, k2 * 4 + l4));
          aw = __builtin_amdgcn_mfma_f32_16x16x32_bf16(x1, y1, aw, 0, 0, 0);
          bf16x8 x2 = *(const bf16x8*)(sAD + swz(mi * 16 + l15, k2 * 4 + l4));
          bf16x8 y2 = *(const bf16x8*)(sUA + swz(16 * w + l15, k2 * 4 + l4));
          aa = __builtin_amdgcn_mfma_f32_16x16x32_bf16(x2, y2, aa, 0, 0, 0);
        }
#pragma unroll
        for (int j = 0; j < 4; j++) { int tok = mi * 16 + l4 * 4 + j; sW[tok * 64 + 16 * w + l15] = aw[j]; sB[tok * 64 + 16 * w + l15] = aa[j]; }
      }
    }
    __syncthreads();
    {
      int tok = tid >> 3, cg8 = (tid & 7) * 8;
      const int base = tok * 64 + cg8;
      float kraw[8], kkv[8], pwv[8], pav[8], rr[8], cK[8], cW[8], cA[8], cKa[8], cRk[8], n2 = 0.f, bs = 0.f;
      *(float4*)&kraw[0] = *(const float4*)(sKD + base); *(float4*)&kraw[4] = *(const float4*)(sKD + base + 4);
      *(float4*)&pwv[0] = *(const float4*)(sW + base); *(float4*)&pwv[4] = *(const float4*)(sW + base + 4);
      *(float4*)&pav[0] = *(const float4*)(sB + base); *(float4*)&pav[4] = *(const float4*)(sB + base + 4);
      *(float4*)&rr[0] = *(const float4*)(sR + base); *(float4*)&rr[4] = *(const float4*)(sR + base + 4);
      *(float4*)&cK[0] = *(const float4*)(kkp + cg8); *(float4*)&cK[4] = *(const float4*)(kkp + cg8 + 4);
      *(float4*)&cW[0] = *(const float4*)(w0 + cg8); *(float4*)&cW[4] = *(const float4*)(w0 + cg8 + 4);
      *(float4*)&cA[0] = *(const float4*)(a0 + cg8); *(float4*)&cA[4] = *(const float4*)(a0 + cg8 + 4);
      *(float4*)&cKa[0] = *(const float4*)(kap + cg8); *(float4*)&cKa[4] = *(const float4*)(kap + cg8 + 4);
      *(float4*)&cRk[0] = *(const float4*)(rkp + cg8); *(float4*)&cRk[4] = *(const float4*)(rkp + cg8 + 4);
#pragma unroll
      for (int e = 0; e < 8; e++) { kkv[e] = kraw[e] * cK[e]; n2 += kkv[e] * kkv[e]; }
      n2 = red8(n2);
      float inv = __builtin_amdgcn_rsqf(fmaxf(n2, 1e-24f));
      float oW[8], oA[8], oB[8], oK[8];
#pragma unroll
      for (int e = 0; e < 8; e++) {
        float pw = cW[e] + pwv[e];
        float dec = __builtin_amdgcn_exp2f(-0.8750388f * sigmoidf_(pw));
        float ic = sigmoidf_(cA[e] + pav[e]);
        float kk = kkv[e] * inv;
        float kd = kraw[e] * (1.f + (ic - 1.f) * cKa[e]);
        oW[e] = dec; oA[e] = -kk; oB[e] = kk * ic; oK[e] = kd;
        bs += rr[e] * kd * cRk[e];
      }
      *(float4*)(sW + base) = *(const float4*)&oW[0]; *(float4*)(sW + base + 4) = *(const float4*)&oW[4];
      *(float4*)(sA + base) = *(const float4*)&oA[0]; *(float4*)(sA + base + 4) = *(const float4*)&oA[4];
      *(float4*)(sB + base) = *(const float4*)&oB[0]; *(float4*)(sB + base + 4) = *(const float4*)&oB[4];
      *(float4*)(sKD + base) = *(const float4*)&oK[0]; *(float4*)(sKD + base + 4) = *(const float4*)&oK[4];
      bs = red8(bs);
      if ((tid & 7) == 0 && vhalf == 0) { int pos = ci * 32 + tok; int t = dir ? (T - 1 - pos) : pos; bon[(size_t)t * 8] = bs; }
    }
    __syncthreads();
    if (ci + 1 < nsub) RW_GLOAD(ci + 1);
    {
      RwOps cur, nxt;
      RW_LOAD(cur, 0);
#pragma unroll 1
      for (int o = 0; o < 4; o++) {
        float yk = 0.f;
#pragma unroll
        for (int ii = 0; ii < 8; ii++) {
          const int i = o * 8 + ii;
          if (i + 1 < 32) RW_LOAD(nxt, i + 1);
          f2v acc = S[0] * cur.a[0];
          acc = S[1] * cur.a[1] + acc; acc = S[2] * cur.a[2] + acc; acc = S[3] * cur.a[3] + acc;
          float sa = red8(acc.x + acc.y);
          f2v sa2 = f2v{sa, sa}, v2 = f2v{cur.v, cur.v};
          f2v y2 = f2v{0.f, 0.f};
#pragma unroll
          for (int e = 0; e < 4; e++) {
            f2v t2 = sa2 * cur.b[e] + v2 * cur.k[e];
            S[e] = S[e] * cur.w[e] + t2;
            y2 = S[e] * cur.r[e] + y2;
          }
          float y = red8(y2.x + y2.y);
          yk = (ks == ii) ? y : yk;
          cur = nxt;
          __builtin_amdgcn_sched_barrier(0);
        }
        sY[(8 * o + ks) * 32 + 8 * w + rp] = f2bf(yk);
      }
    }
    __syncthreads();
    {
      int tok = tid >> 3, c4 = (tid & 7) * 4;
      int pos = ci * 32 + tok; int t = dir ? (T - 1 - pos) : pos;
      *(uint2*)(Yd + (size_t)t * 2048 + c4) = *(const uint2*)(sY + tok * 32 + c4);
    }
  }
  if (!lat && !DBGSTOP) {
    float* o = p->out + O_RWKV + ((size_t)((seq * 2 + l) * 2 + dir) * 8 + head) * 4096 + (size_t)vrow * 64 + ks * 8;
#pragma unroll
    for (int e = 0; e < 4; e++) *(f2v*)(o + 2 * e) = S[e];
  }
}

__device__ __forceinline__ void ggemm_tile(PP p, u16* smem, int id) {
  const u16* P = (const u16*)(p->ws + WS_P);
  const u16* W = (const u16*)(p->ws + WS_W + W_WGU);
  u16* G = (u16*)(p->ws + WS_G);
  int m = id >> 2, n = id & 3;
  f32x4 acc[4][4]; zero_acc<4, 4>(acc);
  gemm_main<4, 4, 1>(acc, P + (size_t)m * 128 * PW + C_WG, PW, W + (size_t)n * 128 * 128, 128, 128, smem);
  store_tile_bf16<4, 4>(acc, smem, G + (size_t)m * 128 * 512 + n * 128, 512);
}

template <int MASK>
__device__ __forceinline__ void post_row(PP p, int l, int g, int r, int lane) {
  const u16* P = (const u16*)(p->ws + WS_P);
  u16* Y = (u16*)(p->ws + WS_Y);
  const float* bon = (const float*)(p->ws + WS_BON);
  const int c0 = lane * 8;
  {
    int grow = g * GROWS + r; int t, T, mi; row_info(grow, t, T, mi);
    const u16* prow = P + (size_t)r * PW;
    u16* y0p = Y + (size_t)r * 2048; const u16* y1p = Y + ((size_t)GROWS + r) * 2048;
    const u16* prm = prow - ((t > 0) ? PW : 0); const u16* prp = prow + ((t < T - 1) ? PW : 0);
    uint4 Ly0[4], Ly1[4];
#pragma unroll
    for (int k = 0; k < 4; k++) { Ly0[k] = *(const uint4*)(y0p + k * 512 + c0); Ly1[k] = *(const uint4*)(y1p + k * 512 + c0); }
    const uint4 Lrg = *(const uint4*)(prow + C_RG + c0), Lsz = *(const uint4*)(prow + C_SZ + c0), Lg = *(const uint4*)((const u16*)(p->ws + WS_G) + (size_t)r * 512 + c0), Lmo = *(const uint4*)(prow + C_MO + c0);
    uint4 Sx0 = *(const uint4*)(prm + C_SX + c0), Sx1 = *(const uint4*)(prow + C_SX + c0), Sx2 = *(const uint4*)(prp + C_SX + c0);
    uint4 Wv0 = *(const uint4*)(prm + C_WV + c0), Wv1 = *(const uint4*)(prow + C_WV + c0), Wv2 = *(const uint4*)(prp + C_WV + c0);
    const float bsum = bon[(size_t)r * 8 + (lane >> 3)] + bon[((size_t)GROWS + r) * 8 + (lane >> 3)];
    { const uint4 z4 = make_uint4(0, 0, 0, 0); if (!(t > 0)) { Sx0 = z4; Wv0 = z4; } if (!(t < T - 1)) { Sx2 = z4; Wv2 = z4; } }
    float a[8], bq[8], s[8], o[8], gt[8];
    if (MASK & 1) { unpack8(Ly0[0], a); unpack8(Ly1[0], bq);
      float sm = 0.f, sq = 0.f;
#pragma unroll
      for (int e = 0; e < 8; e++) { s[e] = a[e] + bq[e]; sm += s[e]; sq += s[e] * s[e]; }
#pragma unroll
      for (int x = 1; x < 16; x <<= 1) { sm += __shfl_xor(sm, x); sq += __shfl_xor(sq, x); }
      float mu = sm * (1.f / 128.f); float var = fmaxf(sq * (1.f / 128.f) - mu * mu, 0.f); float ri = rsqrtf(var + 1e-5f);
      unpack8(Lrg, gt);
#pragma unroll
      for (int e = 0; e < 8; e++) o[e] = siluf_(gt[e]) * (s[e] - mu) * ri;
      *(uint4*)(y0p + c0) = pack8(o); }
    if (MASK & 1) { unpack8(Ly0[1], a); unpack8(Ly1[1], bq);
      float xs[8];
      conv8_rows(Sx0, Sx1, Sx2, p->in[I_SCW] + (size_t)l * 3 * 768, p->in[I_SCB] + (size_t)l * 768, c0, 768, xs);
      int h = lane >> 3;
      float dsum = p->in[I_SD][(l * 2 + 0) * 8 + h] + p->in[I_SD][(l * 2 + 1) * 8 + h];
      unpack8(Lsz, gt);
      float sq = 0.f;
#pragma unroll
      for (int e = 0; e < 8; e++) { s[e] = (a[e] + bq[e] + dsum * xs[e]) * siluf_(gt[e]); sq += s[e] * s[e]; }
      sq = wave_sum(sq);
      float ri = rsqrtf(sq * (1.f / 512.f) + 1e-6f);
      const float* nw = p->in[I_SNORM] + (size_t)l * 512 + c0;
#pragma unroll
      for (int e = 0; e < 8; e++) o[e] = s[e] * ri * nw[e];
      *(uint4*)(y0p + 512 + c0) = pack8(o); }
    if (MASK & 2) { unpack8(Ly0[2], a); unpack8(Ly1[2], bq);
      float sm = 0.f, sq = 0.f;
#pragma unroll
      for (int e = 0; e < 8; e++) { s[e] = a[e] + bq[e]; sm += s[e]; sq += s[e] * s[e]; }
#pragma unroll
      for (int x = 1; x < 8; x <<= 1) { sm += __shfl_xor(sm, x); sq += __shfl_xor(sq, x); }
      float mu = sm * (1.f / 64.f); float var = fmaxf(sq * (1.f / 64.f) - mu * mu, 0.f); float ri = rsqrtf(var + 64e-5f);
      float vv[8];
      conv8_rows(Wv0, Wv1, Wv2, p->in[I_RCW] + (size_t)l * 3 * 1536, nullptr, 1024 + c0, 1536, vv);
      unpack8(Lg, gt);
      const float* lw = p->in[I_RLNW] + (size_t)l * 512 + c0; const float* lbp = p->in[I_RLNB] + (size_t)l * 512 + c0;
#pragma unroll
      for (int e = 0; e < 8; e++) o[e] = ((s[e] - mu) * ri * lw[e] + lbp[e] + bsum * vv[e]) * gt[e];
      *(uint4*)(y0p + 1024 + c0) = pack8(o); }
    if (MASK & 1) { unpack8(Ly0[3], a); unpack8(Ly1[3], bq);
      float sm = 0.f, sq = 0.f;
#pragma unroll
      for (int e = 0; e < 8; e++) { s[e] = a[e] + bq[e]; sm += s[e]; sq += s[e] * s[e]; }
#pragma unroll
      for (int x = 1; x < 16; x <<= 1) { sm += __shfl_xor(sm, x); sq += __shfl_xor(sq, x); }
      float mu = sm * (1.f / 128.f); float var = fmaxf(sq * (1.f / 128.f) - mu * mu, 0.f); float ri = rsqrtf(var + 1e-5f);
      unpack8(Lmo, gt);
      const float* nw = p->in[I_MNORM] + (size_t)l * 512 + c0;
#pragma unroll
      for (int e = 0; e < 8; e++) o[e] = sigmoidf_(gt[e]) * (s[e] - mu) * ri * nw[e];
      *(uint4*)(y0p + 1536 + c0) = pack8(o); }
  }
}

__device__ __forceinline__ void phase_post(PP p, int l, int g) {
  const int lane = ltid() & 63, wid = ltid() >> 6;
  for (int r = blockIdx.x * 4 + wid; r < GROWS; r += gridDim.x * 4) post_row<2>(p, l, g, r, lane);
}

__device__ __forceinline__ void phase_scans(PP p, int l, int g, int cnt_idx, char* smem_raw, const unsigned* st) {
  __shared__ int s_item;
  const int nlat = g ? 5 : 3, lat0 = g ? 3 : 0, nctx = g ? 0 : 32;
  const unsigned slot = st[2], rwcu = st[3];
  const int tid = ltid();
  if (rwcu) {
    if (slot != 0) return;
    int* cnt = (int*)(p->ws + WS_CNT) + cnt_idx * 8;
    const int r0 = nlat * 32, r1 = r0 + nctx * 32;
    while (true) {
      __syncthreads();
      if (tid == 0) s_item = atomicAdd(cnt, 1);
      __syncthreads();
      const int it = __builtin_amdgcn_readfirstlane(s_item);
      if (it >= r1) break;
      LAUNDER(p);
      int seq, j;
      if (it < r0) { seq = 32 + lat0 + it / 32; j = it % 32; }
      else { int q = it - r0; seq = q / 32; j = q % 32; }
      rwkv_scan(p, l, g, seq, (j >> 1) & 7, j & 1, j >> 4, smem_raw);
    }
  } else {
    int* cnt = (int*)(p->ws + WS_CNT) + cnt_idx * 8 + 1;
    const int c0 = nlat * 32, c1 = c0 + nctx * 32;
    int nproc = 0;
    while (true) {
      __syncthreads();
      if (tid == 0) s_item = atomicAdd(cnt, 1);
      __syncthreads();
      const int it = __builtin_amdgcn_readfirstlane(s_item);
      if (it >= c1) break;
      LAUNDER(p);
      int seq, j;
      if (it < c0) { seq = 32 + lat0 + it / 32; j = it % 32; }
      else { int q = it - c0; seq = q / 32; j = q % 32; }
      if (j < 8) chunk_scan<2>(p, l, g, seq, j >> 1, j & 1, smem_raw);
      else if (j < 16) chunk_scan<0>(p, l, g, seq, (j - 8) >> 1, j & 1, smem_raw);
      else chunk_scan<1>(p, l, g, seq, (j - 16) >> 1, j & 1, smem_raw);
      nproc++;
    }
    {
      int* gq = (int*)(p->ws + WS_CNT) + cnt_idx * 8 + 4;
      while (true) {
        __syncthreads();
        if (tid == 0) s_item = atomicAdd(gq, 1);
        __syncthreads();
        const int id = __builtin_amdgcn_readfirstlane(s_item);
        if (id >= 160 * 4) break;
        LAUNDER(p);
        ggemm_tile(p, (u16*)smem_raw, id);
      }
    }
    asm volatile("s_waitcnt vmcnt(0)" ::: "memory");
    __syncthreads();
    if (tid == 0) {
      unsigned* done = (unsigned*)(p->ws + WS_CNT) + cnt_idx * 8 + 2;
      __builtin_amdgcn_fence(__ATOMIC_RELEASE, "agent");
      asm volatile("s_waitcnt vmcnt(0)" ::: "memory");
      (void)xb_add(done, (unsigned)nproc);
      unsigned sp = 0u;
      while (xb_ld(done) < (unsigned)c1) { __builtin_amdgcn_s_sleep(2); if (++sp > (1u << 25)) break; }
      __builtin_amdgcn_fence(__ATOMIC_ACQUIRE, "agent");
      asm volatile("s_waitcnt vmcnt(0)" ::: "memory");
    }
    __syncthreads();
    {
      int* rowq = (int*)(p->ws + WS_CNT) + cnt_idx * 8 + 3;
      const int lane = tid & 63, wid = tid >> 6;
      while (true) {
        __syncthreads();
        if (tid == 0) s_item = atomicAdd(rowq, 1);
        __syncthreads();
        const int rg = __builtin_amdgcn_readfirstlane(s_item);
        if (rg >= GROWS / 16) break;
        LAUNDER(p);
#pragma unroll 1
        for (int k = 0; k < 4; k++) post_row<1>(p, l, g, rg * 16 + wid * 4 + k, lane);
      }
    }
  }
}


__device__ __forceinline__ void phase_merge(PP p, u16* smem) {
  const u16* H = (const u16*)(p->ws + WS_H);
  const u16* Y = (const u16*)(p->ws + WS_Y);
  u16* M = (u16*)(p->ws + WS_Y) + (size_t)GROWS * 2048;
  const u16* WG = (const u16*)(p->ws + WS_W + W_WIN) + (size_t)PW * 1024;
  const u16* WB = (const u16*)(p->ws + WS_W + W_WBR);
  for (int id = blockIdx.x; id < 160 * 16; id += gridDim.x) {
    int m, n; tile_mn(id, 16, m, n);
    f32x4 mg[4][2]; zero_acc<4, 2>(mg);
#pragma unroll 1
    for (int b = 0; b < 4; b++) {
      f32x4 ag[4][2]; zero_acc<4, 2>(ag);
      gemm_main<4, 2, 0>(ag, H + (size_t)m * 128 * 1024, 1024, WG + ((size_t)b * 1024 + n * 64) * 1024, 1024, 1024, smem);
#pragma unroll
      for (int mi = 0; mi < 4; mi++)
#pragma unroll
        for (int ni = 0; ni < 2; ni++)
#pragma unroll
          for (int j = 0; j < 4; j++) ag[mi][ni][j] = sigmoidf_(ag[mi][ni][j]);
      f32x4 ay[4][2]; zero_acc<4, 2>(ay);
      gemm_main<4, 2, 0>(ay, Y + (size_t)m * 128 * 2048 + b * 512, 2048, WB + ((size_t)b * 1024 + n * 64) * 512, 512, 512, smem);
#pragma unroll
      for (int mi = 0; mi < 4; mi++)
#pragma unroll
        for (int ni = 0; ni < 2; ni++) mg[mi][ni] += ag[mi][ni] * ay[mi][ni];
    }
    store_tile_bf16<4, 2>(mg, smem, M + (size_t)m * 128 * 1024 + n * 64, 1024);
  }
}

__device__ __forceinline__ void phase_resgemm(PP p, int l, int g, int which, u16* smem) {
  const u16* A; size_t lda; int K; const u16* W;
  if (which == 0) { A = (const u16*)(p->ws + WS_Y) + (size_t)GROWS * 2048; lda = 1024; K = 1024; W = (const u16*)(p->ws + WS_W + W_WOUT); }
  else { A = (const u16*)(p->ws + WS_Y); lda = FFN; K = FFN; W = (const u16*)(p->ws + WS_W + W_WDN); }
  const float* mod = (const float*)(p->ws + WS_MOD) + (size_t)l * 9 * 6144 + (which ? 5 : 2) * 1024;
  const int lane = ltid() & 63, wid = ltid() >> 6, wr = wid >> 1, wc = wid & 1, l15 = lane & 15, l4 = lane >> 4;
  for (int id = blockIdx.x; id < 160 * 8; id += gridDim.x) {
    int m, n; tile_mn(id, 8, m, n);
    f32x4 acc[4][4]; zero_acc<4, 4>(acc);
    gemm_main<4, 4, 0>(acc, A + (size_t)m * 128 * lda, lda, W + (size_t)n * 128 * K, K, K, smem);
#pragma unroll
    for (int mi = 0; mi < 4; mi++)
#pragma unroll
      for (int j = 0; j < 4; j++) {
        int grow = g * GROWS + m * 128 + wr * 64 + mi * 16 + l4 * 4 + j;
        int t, T, modi; row_info(grow, t, T, modi);
        const float* xin;
        if (l == 0 && which == 0) xin = (grow < 8192) ? p->in[I_XP] + (size_t)grow * 1024 : p->in[I_XS] + (size_t)(grow - 8192) * 1024;
        else xin = p->out + (size_t)grow * 1024;
        float* xo = p->out + (size_t)grow * 1024;
        const float* gp = mod + (size_t)modi * 6144;
#pragma unroll
        for (int ni = 0; ni < 4; ni++) {
          int c = n * 128 + wc * 64 + ni * 16 + l15;
          xo[c] = xin[c] + gp[c] * acc[mi][ni][j];
        }
      }
  }
}

__device__ __forceinline__ void phase_ffnup(PP p, u16* smem) {
  const u16* H = (const u16*)(p->ws + WS_H);
  const u16* W = (const u16*)(p->ws + WS_W + W_WUP);
  u16* U = (u16*)(p->ws + WS_P);
  for (int id = blockIdx.x; id < 160 * 44; id += gridDim.x) {
    int m, n; tile_mn(id, 44, m, n);
    f32x4 acc[4][4]; zero_acc<4, 4>(acc);
    gemm_main<4, 4, 0>(acc, H + (size_t)m * 128 * 1024, 1024, W + (size_t)n * 128 * 1024, 1024, 1024, smem);
    store_tile_bf16<4, 4>(acc, smem, U + (size_t)m * 128 * 5632 + n * 128, 5632);
  }
}

__device__ __forceinline__ void phase_act(PP p, int l, int g) {
  const u16* U = (const u16*)(p->ws + WS_P);
  u16* ACT = (u16*)(p->ws + WS_Y);
  const float* cw = p->in[I_FCW] + (size_t)l * 3 * 5632; const float* cb = p->in[I_FCB] + (size_t)l * 5632;
  const int total = (GROWS / 4) * 352;
  for (int idx = blockIdx.x * 256 + ltid(); idx < total; idx += gridDim.x * 256) {
    const int rb = idx / 352, cc = (idx - rb * 352) * 8, r0 = rb * 4;
    int t0, T, mi; row_info(g * GROWS + r0, t0, T, mi);
    const u16* u0 = U + (size_t)r0 * 5632 + cc;
    const bool hasp = t0 > 0, hasn = t0 + 4 < T;
    uint4 va[6], vg[6];
#pragma unroll
    for (int k = 0; k < 6; k++) {
      int off = k - 1; if (k == 0 && !hasp) off = 0; if (k == 5 && !hasn) off = 3;
      va[k] = *(const uint4*)(u0 + (ptrdiff_t)off * 5632); vg[k] = *(const uint4*)(u0 + (ptrdiff_t)off * 5632 + FFN);
    }
    const uint4 z = make_uint4(0, 0, 0, 0);
    if (!hasp) { va[0] = z; vg[0] = z; }
    if (!hasn) { va[5] = z; vg[5] = z; }
    float wv[3][8], wg[3][8], bv[8], bg[8];
#pragma unroll
    for (int k = 0; k < 3; k++) {
      *(float4*)&wv[k][0] = *(const float4*)(cw + k * 5632 + cc); *(float4*)&wv[k][4] = *(const float4*)(cw + k * 5632 + cc + 4);
      *(float4*)&wg[k][0] = *(const float4*)(cw + k * 5632 + FFN + cc); *(float4*)&wg[k][4] = *(const float4*)(cw + k * 5632 + FFN + cc + 4);
    }
    *(float4*)&bv[0] = *(const float4*)(cb + cc); *(float4*)&bv[4] = *(const float4*)(cb + cc + 4);
    *(float4*)&bg[0] = *(const float4*)(cb + FFN + cc); *(float4*)&bg[4] = *(const float4*)(cb + FFN + cc + 4);
    float pm[8], p0[8], gm[8], g0[8];
    unpack8(va[0], pm); unpack8(va[1], p0); unpack8(vg[0], gm); unpack8(vg[1], g0);
#pragma unroll
    for (int k = 0; k < 4; k++) {
      float pp[8], gp[8], o[8];
      unpack8(va[k + 2], pp); unpack8(vg[k + 2], gp);
#pragma unroll
      for (int e = 0; e < 8; e++) {
        float val = pm[e] * wv[0][e] + p0[e] * wv[1][e] + pp[e] * wv[2][e] + bv[e];
        float gt = gm[e] * wg[0][e] + g0[e] * wg[1][e] + gp[e] * wg[2][e] + bg[e];
        o[e] = val * siluf_(gt);
        pm[e] = p0[e]; p0[e] = pp[e]; gm[e] = g0[e]; g0[e] = gp[e];
      }
      *(uint4*)(ACT + (size_t)(r0 + k) * FFN + cc) = pack8(o);
    }
  }
}

__device__ __forceinline__ void phase_final(PP p) {
  const int lane = ltid() & 63, wid = ltid() >> 6;
  const float* nw = p->in[I_FNORM];
  for (int rg = blockIdx.x * 4 + wid; rg < 2 * GROWS / 4; rg += gridDim.x * 4) {
    float* x = p->out + (size_t)rg * 4 * 1024;
    float4 v[4][4]; float ss[4];
#pragma unroll
    for (int k = 0; k < 4; k++)
#pragma unroll
      for (int i = 0; i < 4; i++) v[k][i] = *(const float4*)(x + k * 1024 + i * 256 + lane * 4);
#pragma unroll
    for (int k = 0; k < 4; k++) {
      float a_ = 0.f;
#pragma unroll
      for (int i = 0; i < 4; i++) a_ += v[k][i].x * v[k][i].x + v[k][i].y * v[k][i].y + v[k][i].z * v[k][i].z + v[k][i].w * v[k][i].w;
      ss[k] = a_;
    }
#pragma unroll
    for (int o = 32; o > 0; o >>= 1) {
#pragma unroll
      for (int k = 0; k < 4; k++) ss[k] += __shfl_xor(ss[k], o);
    }
#pragma unroll
    for (int i = 0; i < 4; i++) {
      int c = i * 256 + lane * 4; float4 w4 = *(const float4*)(nw + c);
#pragma unroll
      for (int k = 0; k < 4; k++) {
        float rinv = rsqrtf(ss[k] * (1.f / 1024.f) + 1e-6f);
        float4 o = make_float4(v[k][i].x * rinv * w4.x, v[k][i].y * rinv * w4.y, v[k][i].z * rinv * w4.z, v[k][i].w * rinv * w4.w);
        *(float4*)(x + k * 1024 + c) = o;
      }
    }
  }
}

__device__ __forceinline__ void phase_dump(PP p) {
  const u16* Y = (const u16*)(p->ws + WS_Y);
  const float* bon = (const float*)(p->ws + WS_BON);
  for (size_t i = (size_t)blockIdx.x * 256 + ltid(); i < (size_t)2 * GROWS * 1024; i += (size_t)gridDim.x * 256) {
    float v = 0.f;
    if (i < (size_t)GROWS * 2048) { int col = (int)(i & 2047); bool isr = (col >= 1024 && col < 1536); if (isr == (DUMPSEL != 0)) v = bf2f(Y[i]) + 2.f * bf2f(Y[i + (size_t)GROWS * 2048]); }
    if (DUMPSEL && i < (size_t)2 * GROWS * 8) v += bon[i];
    p->out[i] = v;
  }
}

#define WS_BAR   WS_END
#define WS_CU    (WS_END + 16384ull)
#define XB_TMO      128
#define XB_XCNT(j)  (256  + 64 * (j))
#define XB_XSUB(j)  (1280 + 64 * (j))
#define XB_XGEN(j)  (2304 + 64 * (j))
#define XB_TOP      3328
#define XB_TOPGEN   3392
#define XCD_BAR_WORDS 3456
#define XB_SPIN_CAP (1u << 25)
__device__ __forceinline__ unsigned xb_xcc_id() { return (unsigned)__builtin_amdgcn_s_getreg((3 << 11) | 20) & 0xFu; }
#define XB_SPIN(cond, bar) do { unsigned _sp = 0; while (cond) { __builtin_amdgcn_s_sleep(1); \
    if ((++_sp & 255u) == 0u) { if (xb_ld(&(bar)[XB_TMO])) break; if (_sp > XB_SPIN_CAP) { atomicAdd(&(bar)[XB_TMO], 1u); break; } } } } while (0)
__device__ __forceinline__ void xcd_barrier_complete(unsigned* bar, unsigned x, unsigned& nloc, unsigned& nx) {
  const unsigned G = gridDim.x;
  unsigned sum, cnt, mine, sp = 0u;
  for (;;) {
    sum = 0u; cnt = 0u; mine = 0u;
#pragma unroll
    for (unsigned j = 0; j < 16; ++j) { const unsigned c = xb_ld(&bar[XB_XCNT(j)]); sum += c; cnt += (c > 0u) ? 1u : 0u; mine = (j == x) ? c : mine; }
    if (sum == G) break;
    __builtin_amdgcn_s_sleep(1);
    if ((++sp & 255u) == 0u) { if (xb_ld(&bar[XB_TMO])) break; if (sp > XB_SPIN_CAP) { atomicAdd(&bar[XB_TMO], 1u); break; } }
  }
  nloc = mine > 0u ? mine : 1u; nx = cnt > 0u ? cnt : 1u;
}
__device__ __forceinline__ void xcd_barrier(unsigned* bar, volatile unsigned* st) {
  asm volatile("s_waitcnt vmcnt(0)" ::: "memory");
  __syncthreads();
  if (ltid() == 0) {
    const unsigned x = xb_xcc_id();
    __builtin_amdgcn_s_waitcnt(0);
    unsigned nloc = st[0], nx = st[1];
    if (nloc == 0u) { xcd_barrier_complete(bar, x, nloc, nx); st[0] = nloc; st[1] = nx; }
    const unsigned old = xb_add(&bar[XB_XSUB(x)], 1u);
    const unsigned gen = old / nloc;
    if (old + 1u == (gen + 1u) * nloc) {
      __builtin_amdgcn_fence(__ATOMIC_RELEASE, "agent");
      asm volatile("s_waitcnt vmcnt(0)" ::: "memory");
      const unsigned og = xb_add(&bar[XB_TOP], 1u);
      const unsigned tg = og / nx;
      if (og + 1u == (tg + 1u) * nx) xb_add(&bar[XB_TOPGEN], 1u);
      else XB_SPIN(xb_ld(&bar[XB_TOPGEN]) == tg, bar);
      __builtin_amdgcn_fence(__ATOMIC_ACQUIRE, "agent");
      xb_add(&bar[XB_XGEN(x)], 1u);
      asm volatile("s_waitcnt vmcnt(0)" ::: "memory");
    } else {
      XB_SPIN(xb_ld(&bar[XB_XGEN(x)]) == gen, bar);
      __builtin_amdgcn_fence(__ATOMIC_ACQUIRE, "agent");
      asm volatile("s_waitcnt vmcnt(0)" ::: "memory");
    }
  }
  __syncthreads();
}

#define NPHASES 42
#ifndef DBGSTOP
#define DBGSTOP 0
#endif
#ifndef PMASK
#define PMASK 0xFFFF
#endif
__global__ void __launch_bounds__(256, 2) mega(Params pval, int lo, int hi) {
  __shared__ __attribute__((aligned(16))) char smem_raw[79872];
  __shared__ __attribute__((aligned(16))) unsigned xb_st[4];
  unsigned* xbar = (unsigned*)(((PP)__builtin_amdgcn_kernarg_segment_ptr())->ws + WS_BAR);
  if (ltid() < 4) xb_st[ltid()] = 0u;
  __syncthreads();
  if (ltid() == 0) {
    (void)xb_add(&xbar[XB_XCNT(xb_xcc_id())], 1u);
    unsigned* cu = (unsigned*)(((PP)__builtin_amdgcn_kernarg_segment_ptr())->ws + WS_CU);
    const unsigned hw = (unsigned)__builtin_amdgcn_s_getreg((31 << 11) | 4);
    const unsigned key = (xb_xcc_id() << 8) | ((hw >> 8) & 0xFFu);
    const unsigned slot = xb_add(&cu[key], 1u);
    unsigned rank = 0u;
    if (slot == 0u) { rank = xb_add(&cu[8192], 1u); __hip_atomic_store(&cu[4096 + key], rank + 1u, __ATOMIC_RELAXED, __HIP_MEMORY_SCOPE_AGENT); }
    (void)xb_add(&cu[8193], 1u);
    { unsigned sp = 0u; while (xb_ld(&cu[8193]) < gridDim.x) { __builtin_amdgcn_s_sleep(2); if (++sp > (1u << 24)) break; } }
    if (slot != 0u) { unsigned r = 0u, sp = 0u; while ((r = xb_ld(&cu[4096 + key])) == 0u) { __builtin_amdgcn_s_sleep(2); if (++sp > (1u << 24)) break; } rank = (r > 0u) ? r - 1u : 0xFFFFu; }
    const unsigned ncu = xb_ld(&cu[8192]);
    unsigned nr = (ncu * 5u) / 8u; if (nr > 160u) nr = 160u;
    xb_st[2] = slot; xb_st[3] = (rank < nr) ? 1u : 0u;
  }
  __syncthreads();
  for (int ph = lo; ph < hi; ph++) {
    if (ph > lo) {
      if (ph == lo + 1) cg::this_grid().sync();
      else xcd_barrier((unsigned*)(((PP)__builtin_amdgcn_kernarg_segment_ptr())->ws + WS_BAR), xb_st);
    }
    PP p = (PP)__builtin_amdgcn_kernarg_segment_ptr();
    LAUNDER(p);
    if (ph == 0) { phase_prep(p, smem_raw); continue; }
    if (ph == NPHASES - 1) { phase_final(p); continue; }
    int q = ph - 1; int lg = q / 10, st = q % 10; int l = lg >> 1, g = lg & 1;
    switch (st) {
      case 0: phase_norm(p, l, g, 0); if (l == 1 && g == 0) conv_weights(p, 1, (u16*)smem_raw); break;
      case 1: phase_gemm1(p, l, g, (u16*)smem_raw); break;
      case 2: phase_scans(p, l, g, ph, smem_raw, xb_st); break;
      case 3: phase_post(p, l, g); break;
      case 4: phase_merge(p, (u16*)smem_raw); break;
      case 5: phase_resgemm(p, l, g, 0, (u16*)smem_raw); break;
      case 6: phase_norm(p, l, g, 1); break;
      case 7: phase_ffnup(p, (u16*)smem_raw); break;
      case 8: phase_act(p, l, g); break;
      case 9: phase_resgemm(p, l, g, 1, (u16*)smem_raw); break;
    }
  }
}

extern "C" void kernel_launch(void* const* d_in, const int* in_sizes, int n_in, void* d_out, int out_size,
                              void* d_ws, size_t ws_size, hipStream_t stream) {
  static int grid_blocks = 0;
  if (!grid_blocks) {
    int dev = 0, cus = 0, per_cu = 0;
    hipGetDevice(&dev);
    hipDeviceGetAttribute(&cus, hipDeviceAttributeMultiprocessorCount, dev);
    hipOccupancyMaxActiveBlocksPerMultiprocessor(&per_cu, mega, 256, 0);
    if (per_cu < 1) per_cu = 1;
    if (per_cu > 2) per_cu = 2;
    grid_blocks = cus * per_cu;
  }
  Params p;
  memset(&p, 0, sizeof(p));
  for (int i = 0; i < 43; i++) p.in[i] = (const float*)d_in[i];
  p.out = (float*)d_out;
  p.ws = (char*)d_ws;
  if (ws_size < WS_G + (size_t)GROWS * 1024) { fprintf(stderr, "workspace too small: %zu < %llu\n", ws_size, (unsigned long long)WS_END); return; }
  hipMemsetAsync(d_ws, 0, 4096, stream);
  hipMemsetAsync((char*)d_ws + WS_BAR, 0, 16384 + 36864, stream);
#if MEGA
  int lo = 0, hi = (DBGSTOP > 0) ? DBGSTOP + 1 : NPHASES;
  void* args[] = {&p, &lo, &hi};
  hipError_t e = hipLaunchCooperativeKernel((void*)mega, dim3(grid_blocks), dim3(256), args, 0, stream);
  if (e != hipSuccess) fprintf(stderr, "cooperative launch failed: %s (grid %d)\n", hipGetErrorString(e), grid_blocks);
#else
  for (int ph = 0; ph < NPHASES; ph++) mega<<<grid_blocks, 256, 0, stream>>>(p, ph, ph + 1);
#endif
}
```
